# Optimizing an MI355X kernel written in HIP

```python
import math
import jax, jax.numpy as jnp
from jax import lax
import numpy as np

D_MODEL = 1024
BATCH = 16
SEQ = 4096
DEPTH = 1

GDN_HEADS = 8
GDN_HEAD_DIM = 128
GDN_WIDTH = GDN_HEADS * GDN_HEAD_DIM
GDN_CONV = 4
GDN_CHUNK = 64
SC_WIDTH = D_MODEL
SC_CONV = 3
N_EXPERTS = 32
TOP_K = 4
D_FF = D_MODEL
SWIGLU_LIMIT = 7.0
SWIGLU_ALPHA = 1.702
MOE_BLOCK = 128
NORM_EPS = 1e-6
IN_SPLITS = (3 * GDN_WIDTH, GDN_WIDTH, GDN_HEADS, GDN_HEADS, SC_WIDTH, SC_WIDTH, SC_WIDTH, D_MODEL, D_MODEL)
D_IN = 4 * GDN_WIDTH + 2 * GDN_HEADS + 3 * SC_WIDTH + 2 * D_MODEL

kernel_name = 'hybrid_gdn_shortconv_moe_block'


def rms_norm(x, g):
    xf = x.astype(jnp.float32)
    y = xf * lax.rsqrt(jnp.mean(xf * xf, axis=-1, keepdims=True) + NORM_EPS)
    return (y * g.astype(jnp.float32)).astype(x.dtype)


def l2_normalize(x):
    xf = x.astype(jnp.float32)
    return xf * lax.rsqrt(jnp.sum(xf * xf, axis=-1, keepdims=True) + NORM_EPS)


def causal_depthwise_conv(x, w):
    K = w.shape[0]
    S = x.shape[1]
    xp = jnp.pad(x, ((0, 0), (K - 1, 0), (0, 0)))
    y = w[0] * xp[:, 0:S]
    for j in range(1, K):
        y = y + w[j] * xp[:, j:j + S]
    return y


def gated_delta_rule_chunked(q, k, v, g, beta):
    Bn, S, H, Dk = q.shape
    Dv = v.shape[-1]
    C = GDN_CHUNK
    N = S // C

    def chunks(t):
        t = t.reshape((Bn, N, C, H) + t.shape[3:])
        return jnp.moveaxis(t, (1, 3), (0, 2))

    q = chunks(q) * (Dk ** -0.5)
    k = chunks(k)
    v = chunks(v)
    g = chunks(g)
    beta = chunks(beta)
    gcum = jnp.cumsum(g, axis=-1)
    idx = jnp.arange(C)
    causal = idx[:, None] >= idx[None, :]
    strict = idx[:, None] > idx[None, :]
    diff = gcum[..., :, None] - gcum[..., None, :]
    decay = jnp.where(causal, jnp.exp(jnp.where(causal, diff, 0.0)), 0.0)
    kb = k * beta[..., None]
    Lm = jnp.where(strict, jnp.einsum('nbhid,nbhjd->nbhij', kb, k) * decay, 0.0)
    eye = jnp.eye(C, dtype=Lm.dtype)
    T = lax.linalg.triangular_solve(Lm + eye, jnp.broadcast_to(eye, Lm.shape),
                                    left_side=True, lower=True, unit_diagonal=True)
    u = T @ (v * beta[..., None])
    w = T @ (kb * jnp.exp(gcum)[..., None])
    aqk = jnp.einsum('nbhid,nbhjd->nbhij', q, k) * decay
    qg = q * jnp.exp(gcum)[..., None]
    g_last = gcum[..., -1]
    kd = k * jnp.exp(g_last[..., None] - gcum)[..., None]

    def step(state, inp):
        w_n, u_n, qg_n, aqk_n, kd_n, gl_n = inp
        v_new = u_n - w_n @ state
        o_n = qg_n @ state + aqk_n @ v_new
        state = state * jnp.exp(gl_n)[..., None, None] + jnp.einsum('bhck,bhcv->bhkv', kd_n, v_new)
        return state, o_n

    state0 = jnp.zeros((Bn, H, Dk, Dv), jnp.float32)
    _, o = lax.scan(step, state0, (w, u, qg, aqk, kd, g_last))
    return jnp.moveaxis(o, (0, 2), (1, 3)).reshape(Bn, S, H, Dv)


def hybrid_mixer(xn, w_in, gdn_conv_w, gdn_A_log, gdn_dt_bias, gdn_norm_g, w_o_gdn,
                 sconv_w, w_o_sconv, w_mix_out):
    Bn, S, _ = xn.shape
    proj = xn @ w_in
    offsets = np.cumsum(IN_SPLITS)[:-1].tolist()
    qkv, z, a, b, xs, gate_b, gate_c, gate_A, gate_B = jnp.split(proj, offsets, axis=-1)

    qkv = jax.nn.silu(causal_depthwise_conv(qkv, gdn_conv_w))
    q, k, v = jnp.split(qkv, 3, axis=-1)
    q = l2_normalize(q.reshape(Bn, S, GDN_HEADS, GDN_HEAD_DIM))
    k = l2_normalize(k.reshape(Bn, S, GDN_HEADS, GDN_HEAD_DIM))
    v = v.reshape(Bn, S, GDN_HEADS, GDN_HEAD_DIM).astype(jnp.float32)
    beta = jax.nn.sigmoid(b.astype(jnp.float32))
    g = -jnp.exp(gdn_A_log.astype(jnp.float32)) * jax.nn.softplus(
        a.astype(jnp.float32) + gdn_dt_bias.astype(jnp.float32))
    o = gated_delta_rule_chunked(q, k, v, g, beta).astype(xn.dtype)
    o = rms_norm(o, gdn_norm_g) * jax.nn.silu(z.reshape(Bn, S, GDN_HEADS, GDN_HEAD_DIM))
    y_a = o.reshape(Bn, S, GDN_WIDTH) @ w_o_gdn

    y_b = (gate_b * causal_depthwise_conv(gate_c * xs, sconv_w)) @ w_o_sconv

    merged = jax.nn.sigmoid(gate_A) * y_a + jax.nn.sigmoid(gate_B) * y_b
    return merged @ w_mix_out


def moe_ffn(xn, w_router, b_router, w_gate_up, b_gate_up, w_down, b_down):
    Bn, S, D = xn.shape
    Tn = Bn * S
    TK = Tn * TOP_K
    xf = xn.reshape(Tn, D)
    logits = xf.astype(jnp.float32) @ w_router.astype(jnp.float32) + b_router.astype(jnp.float32)
    top_vals, top_idx = lax.top_k(logits, TOP_K)
    top_w = jax.nn.softmax(top_vals, axis=-1).astype(xn.dtype)

    e_flat = top_idx.reshape(-1)
    tok_flat = jnp.arange(TK, dtype=jnp.int32) // TOP_K
    order = jnp.argsort(e_flat)
    e_sorted = e_flat[order]
    tok_sorted = tok_flat[order]
    w_sorted = top_w.reshape(-1)[order]
    counts = jnp.bincount(e_flat, length=N_EXPERTS)
    start = jnp.cumsum(counts) - counts
    pcounts = ((counts + MOE_BLOCK - 1) // MOE_BLOCK) * MOE_BLOCK
    pend = jnp.cumsum(pcounts)
    pstart = pend - pcounts
    dest = pstart[e_sorted] + (jnp.arange(TK, dtype=jnp.int32) - start[e_sorted])
    n_blocks = (TK + N_EXPERTS * (MOE_BLOCK - 1) + MOE_BLOCK - 1) // MOE_BLOCK
    x_pad = jnp.zeros((n_blocks * MOE_BLOCK, D), xn.dtype).at[dest].set(xf[tok_sorted])
    block_e = jnp.minimum(jnp.searchsorted(pend, jnp.arange(n_blocks) * MOE_BLOCK, side='right'),
                          N_EXPERTS - 1)

    def expert_block(args):
        xb, e = args
        gu = xb @ w_gate_up[e] + b_gate_up[e]
        gate = jnp.minimum(gu[:, :D_FF], SWIGLU_LIMIT)
        up = jnp.clip(gu[:, D_FF:], -SWIGLU_LIMIT, SWIGLU_LIMIT)
        hid = (up + 1.0) * gate * jax.nn.sigmoid(SWIGLU_ALPHA * gate)
        return hid @ w_down[e] + b_down[e]

    y_blocks = lax.map(expert_block, (x_pad.reshape(n_blocks, MOE_BLOCK, D), block_e))
    y_sorted = y_blocks.reshape(n_blocks * MOE_BLOCK, D)[dest]
    out = jnp.zeros((Tn, D), xn.dtype).at[tok_sorted].add(y_sorted * w_sorted[:, None])
    return out.reshape(Bn, S, D)


def setup_inputs(seed: int = 0) -> dict:
    key = jax.random.key(seed)
    ks = jax.random.split(key, 20)
    f32 = jnp.float32
    L = DEPTH

    def nrm(k, shape, fan_in):
        return jax.random.normal(k, shape, f32) * (fan_in ** -0.5)

    def gain(k, shape):
        return 1.0 + 0.02 * jax.random.normal(k, shape, f32)

    def small(k, shape):
        return 0.01 * jax.random.normal(k, shape, f32)

    dt = jnp.exp(jax.random.uniform(ks[6], (L, GDN_HEADS), f32, math.log(1e-3), math.log(1e-1)))
    return {
        'x': jax.random.normal(ks[0], (BATCH, SEQ, D_MODEL), f32),
        'norm_mix_g': gain(ks[1], (L, D_MODEL)),
        'w_in': nrm(ks[2], (L, D_MODEL, D_IN), D_MODEL),
        'gdn_conv_w': nrm(ks[3], (L, GDN_CONV, 3 * GDN_WIDTH), GDN_CONV),
        'gdn_A_log': jnp.log(jax.random.uniform(ks[4], (L, GDN_HEADS), f32, 1.0, 16.0)),
        'gdn_dt_bias': dt + jnp.log(-jnp.expm1(-dt)),
        'gdn_norm_g': gain(ks[5], (L, GDN_HEAD_DIM)),
        'w_o_gdn': nrm(ks[7], (L, GDN_WIDTH, D_MODEL), GDN_WIDTH),
        'sconv_w': nrm(ks[8], (L, SC_CONV, SC_WIDTH), SC_CONV),
        'w_o_sconv': nrm(ks[9], (L, SC_WIDTH, D_MODEL), SC_WIDTH),
        'w_mix_out': nrm(ks[10], (L, D_MODEL, D_MODEL), D_MODEL),
        'norm_ffn_g': gain(ks[11], (L, D_MODEL)),
        'w_router': nrm(ks[12], (L, D_MODEL, N_EXPERTS), D_MODEL),
        'b_router': small(ks[13], (L, N_EXPERTS)),
        'w_gate_up': nrm(ks[14], (L, N_EXPERTS, D_MODEL, 2 * D_FF), D_MODEL),
        'b_gate_up': small(ks[15], (L, N_EXPERTS, 2 * D_FF)),
        'w_down': nrm(ks[16], (L, N_EXPERTS, D_FF, D_MODEL), D_FF),
        'b_down': small(ks[17], (L, N_EXPERTS, D_MODEL)),
        'norm_final_g': gain(ks[18], (D_MODEL,)),
    }


def reference(x, norm_mix_g, w_in, gdn_conv_w, gdn_A_log, gdn_dt_bias, gdn_norm_g, w_o_gdn,
              sconv_w, w_o_sconv, w_mix_out, norm_ffn_g, w_router, b_router, w_gate_up,
              b_gate_up, w_down, b_down, norm_final_g):
    h = x
    for l in range(DEPTH):
        h = h + hybrid_mixer(rms_norm(h, norm_mix_g[l]), w_in[l], gdn_conv_w[l], gdn_A_log[l],
                             gdn_dt_bias[l], gdn_norm_g[l], w_o_gdn[l], sconv_w[l], w_o_sconv[l],
                             w_mix_out[l])
        h = h + moe_ffn(rms_norm(h, norm_ffn_g[l]), w_router[l], b_router[l], w_gate_up[l],
                        b_gate_up[l], w_down[l], b_down[l])
    return rms_norm(h, norm_final_g)
```

```cpp
#include <hip/hip_runtime.h>
#include <cstdio>
#include <cstdint>

#ifndef ONLY
#define ONLY -1
#endif
#ifndef PROBE_MASK
#define PROBE_MASK 0
#endif
#define REPS(k) for (int rep_ = 0; rep_ < (((PROBE_MASK >> (k)) & 1) ? 2 : 1); ++rep_)
#ifndef MK_MULTI
#define MK_MULTI 0
#endif

#define LAS __attribute__((address_space(3)))
typedef unsigned short bf16_t;
typedef short bf16x8 __attribute__((ext_vector_type(8)));
typedef float f32x4 __attribute__((ext_vector_type(4)));
typedef float f32x2 __attribute__((ext_vector_type(2)));
typedef unsigned u32x4 __attribute__((ext_vector_type(4)));
typedef unsigned u32x2 __attribute__((ext_vector_type(2)));
typedef int i32x4 __attribute__((ext_vector_type(4)));

constexpr int D = 1024, NB = 16, SEQ = 4096, NH = 8, HD = 128, NE = 32;
constexpr int NSEG = 2, L = SEQ / NSEG, LLOG = 11, MS = NB * L;
static_assert((1 << LLOG) == L, "LLOG");
constexpr int DIN = 9232, NIN = 9216;
constexpr int MAXT = (4 * MS + NE * 255) / 256;
static_assert(MAXT * 4 <= 147456 - (131072 + 1024), "tile table fits the LDS tail");
constexpr int NG = MS / 128;
constexpr float EPS = 1e-6f;

constexpr size_t MiB = (size_t)1 << 20;
constexpr size_t WS_CTL = 0, CTL_BYTES = 1 * MiB;
constexpr size_t WS_WIN = 1 * MiB;
constexpr size_t WS_WAB = 19 * MiB;
constexpr size_t WS_WR = 19 * MiB + 65536;
constexpr size_t WS_BGU16 = 19 * MiB + 131072;
constexpr size_t WS_BDN16 = 19 * MiB + 131072 + 131072;
constexpr size_t WS_WOG = 20 * MiB, WS_WOS = 22 * MiB, WS_WMX = 24 * MiB;
constexpr size_t WS_WGU = 26 * MiB;
constexpr size_t WS_WDN = 154 * MiB;
constexpr size_t WS_STATE = 218 * MiB;
constexpr size_t WS_MISC = 226 * MiB;
constexpr size_t WS_RS1 = WS_MISC;
constexpr size_t WS_RS2 = WS_RS1 + (size_t)MS * 4;
constexpr size_t WS_GB = WS_RS2 + (size_t)MS * 4;
constexpr size_t WS_TOPE = WS_GB + (size_t)MS * 64;
constexpr size_t WS_TOPW = WS_TOPE + (size_t)MS * 16;
constexpr size_t WS_DEST = WS_TOPW + (size_t)MS * 16;
constexpr size_t WS_HIST = WS_DEST + (size_t)MS * 16;
constexpr size_t WS_ROWTOK = WS_HIST + (size_t)NG * 128;
constexpr size_t WS_HALOQ = WS_ROWTOK + (size_t)MAXT * 1024;
constexpr size_t WS_HALOS = WS_HALOQ + (size_t)2 * 16 * 3 * 3072 * 2;
constexpr size_t WS_META = WS_HALOS + (size_t)2 * 16 * 2 * 1024 * 2;
constexpr size_t WS_MISC_END = WS_META + 4096 + (size_t)MAXT * 4;
constexpr size_t WS_SLOTS = 234 * MiB;
static_assert(WS_MISC_END <= WS_SLOTS, "misc region");
constexpr size_t SLOT = (size_t)MS * D * 2;
constexpr int NSLOT = 11;
constexpr size_t WS_QC = WS_SLOTS + NSLOT * SLOT;
constexpr size_t WS_END = WS_QC + SLOT;
constexpr size_t HID_BYTES = (size_t)MAXT * 256 * 2048;
constexpr size_t WS_HID = WS_SLOTS, WS_Y = WS_SLOTS + ((HID_BYTES + MiB - 1) / MiB) * MiB;
static_assert(WS_Y + HID_BYTES <= WS_SLOTS + 9 * SLOT, "MoE buffers overlay the dead projection slots");
constexpr int CW_BAR = 4096;

constexpr int LDS_BYTES = 147456, MISC_OFF = 131072 + 320, TILE_E_OFF = 131072 + 1024;

typedef __bf16 bf16v2_t __attribute__((ext_vector_type(2)));
__device__ __forceinline__ unsigned cvt_pk_bf16(float lo, float hi) { const f32x2 v = {lo, hi}; return __builtin_bit_cast(unsigned, __builtin_convertvector(v, bf16v2_t)); }
__device__ __forceinline__ float bflo(unsigned w) { return __uint_as_float(w << 16); }
__device__ __forceinline__ float bfhi(unsigned w) { return __uint_as_float(w & 0xffff0000u); }
__device__ __forceinline__ float sigmoidf_(float x) { return __builtin_amdgcn_rcpf(1.0f + __expf(-x)); }
__device__ __forceinline__ int grow(int seg, int r) { return ((r >> LLOG) << 12) + seg * L + (r & (L - 1)); }
__device__ __forceinline__ float sat8(float v) { return __builtin_amdgcn_fmed3f(v, -448.0f, 448.0f); }
__device__ __forceinline__ unsigned cvt_pk4_fp8(float a, float b, float c, float d) { int w = __builtin_amdgcn_cvt_pk_fp8_f32(a, b, 0, false); w = __builtin_amdgcn_cvt_pk_fp8_f32(c, d, w, true); return (unsigned)w; }
#define LDS_WAIT() asm volatile("s_waitcnt lgkmcnt(0)" ::: "memory")
__device__ __forceinline__ int wave_id() { int t = (int)threadIdx.x; asm volatile("" : "+v"(t)); return __builtin_amdgcn_readfirstlane(t >> 6); }

#define XB_TMO      128
#define XB_XCNT(j)  (256  + 64 * (j))
#define XB_XSUB(j)  (1280 + 64 * (j))
#define XB_XGEN(j)  (2304 + 64 * (j))
#define XB_TOP      3328
#define XB_TOPGEN   3392
#define XCD_BAR_WORDS 3456
#define XB_SPIN_CAP (1u << 20)
__device__ __forceinline__ unsigned xb_ld(unsigned* p)              { return __hip_atomic_load(p, __ATOMIC_RELAXED, __HIP_MEMORY_SCOPE_AGENT); }
__device__ __forceinline__ unsigned xb_add(unsigned* p, unsigned v) { return __hip_atomic_fetch_add(p, v, __ATOMIC_RELAXED, __HIP_MEMORY_SCOPE_AGENT); }
__device__ __forceinline__ unsigned xb_xcc_id() { return (unsigned)__builtin_amdgcn_s_getreg((3 << 11) | 20) & 0xFu; }
#define XB_SPIN(cond, bar) do { unsigned _sp = 0; while (cond) { __builtin_amdgcn_s_sleep(1); \
    if ((++_sp & 255u) == 0u) { if (xb_ld(&(bar)[XB_TMO])) break; if (_sp > XB_SPIN_CAP) { atomicAdd(&(bar)[XB_TMO], 1u); break; } } } } while (0)
struct XcdBarrier { unsigned* bar; unsigned x; volatile LAS unsigned* st; };
__device__ __forceinline__ XcdBarrier xcd_barrier_post(unsigned* bar, volatile LAS unsigned* st) {
    XcdBarrier b; b.bar = bar; b.x = xb_xcc_id(); b.st = st;
    if (threadIdx.x == 0) (void)xb_add(&bar[XB_XCNT(b.x)], 1u);
    return b;
}
__device__ __forceinline__ void xcd_barrier_complete(unsigned* bar, unsigned x, unsigned& nloc, unsigned& nx) {
    const unsigned G = gridDim.x * gridDim.y * gridDim.z;
    unsigned sum, cnt, mine, sp = 0u;
    for (;;) {
        sum = 0u; cnt = 0u; mine = 0u;
#pragma unroll
        for (unsigned j = 0; j < 16; ++j) { const unsigned c = xb_ld(&bar[XB_XCNT(j)]); sum += c; cnt += (c > 0u) ? 1u : 0u; mine = (j == x) ? c : mine; }
        if (sum == G) break;
        __builtin_amdgcn_s_sleep(1);
        if ((++sp & 255u) == 0u) { if (xb_ld(&bar[XB_TMO])) break; if (sp > XB_SPIN_CAP) { atomicAdd(&bar[XB_TMO], 1u); break; } }
    }
    nloc = mine > 0u ? mine : 1u; nx = cnt > 0u ? cnt : 1u;
}
__device__ __forceinline__ void xcd_barrier(const XcdBarrier& b) {
    asm volatile("s_waitcnt vmcnt(0)" ::: "memory");
    __syncthreads();
    if (threadIdx.x == 0) {
        unsigned* bar = b.bar;
        __builtin_amdgcn_s_waitcnt(0);
        unsigned nloc = b.st[0], nx = b.st[1];
        if (nloc == 0u) { xcd_barrier_complete(bar, b.x, nloc, nx); b.st[0] = nloc; b.st[1] = nx; }
        const unsigned old = xb_add(&bar[XB_XSUB(b.x)], 1u);
        const unsigned gen = old / nloc;
        if (old + 1u == (gen + 1u) * nloc) {
            __builtin_amdgcn_fence(__ATOMIC_RELEASE, "agent");
            asm volatile("s_waitcnt vmcnt(0)" ::: "memory");
            const unsigned og = xb_add(&bar[XB_TOP], 1u);
            const unsigned tg = og / nx;
            if (og + 1u == (tg + 1u) * nx) xb_add(&bar[XB_TOPGEN], 1u);
            else XB_SPIN(xb_ld(&bar[XB_TOPGEN]) == tg, bar);
            __builtin_amdgcn_fence(__ATOMIC_ACQUIRE, "agent");
            xb_add(&bar[XB_XGEN(b.x)], 1u);
            asm volatile("s_waitcnt vmcnt(0)" ::: "memory");
        } else {
            XB_SPIN(xb_ld(&bar[XB_XGEN(b.x)]) == gen, bar);
            __builtin_amdgcn_fence(__ATOMIC_ACQUIRE, "agent");
            asm volatile("s_waitcnt vmcnt(0)" ::: "memory");
        }
    }
    __syncthreads();
}

namespace pg8 {
constexpr int BM = 256, BK = 64, HALF = 128, HTB = HALF * BK * 2, NXCD = 8, WGM = 8, K = 1024;
__device__ __forceinline__ int lds_byte(int r, int c) { const int st = (r >> 4) * 2 + (c >> 5), rr = r & 15, cc = c & 31, ob = rr * 64 + cc * 2; return st * 1024 + (ob ^ (((ob >> 9) & 1) << 5)); }
__device__ __forceinline__ void stage_rc(int b, int& R, int& C) { const int st = b / 1024, sb = b % 1024, swz = sb ^ (((sb >> 9) & 1) << 5); R = (st >> 1) * 16 + swz / 64; C = (st & 1) * 32 + (swz % 64) / 2; }
__device__ __forceinline__ int perm32(int rho) { const int n = rho >> 4, i = rho & 15; return 8 * (i >> 2) + 4 * n + (i & 3); }
struct Unit { int pm, pn, part; };
typedef int i32x8 __attribute__((ext_vector_type(8)));
typedef int i32x4v __attribute__((ext_vector_type(4)));
__device__ __forceinline__ i32x8 cat8(bf16x8 a, bf16x8 b) { return __builtin_shufflevector(__builtin_bit_cast(i32x4v, a), __builtin_bit_cast(i32x4v, b), 0, 1, 2, 3, 4, 5, 6, 7); }
struct Order {
    int nM, nN, nwg, G, c, wgm;
    __device__ __forceinline__ void init(int nM_, int nN_, int G_, int c_, int wgm_ = 8) { nM = nM_; nN = nN_; nwg = nM * nN; G = G_; c = c_; wgm = wgm_; }
    __device__ __forceinline__ bool next(int i, Unit& u) const {
        const long Lx = (long)i * G + c; if (Lx >= nwg) return false;
        int wgid = (int)Lx; { const int q = nwg / NXCD, r = nwg % NXCD, xcd = wgid % NXCD, off = wgid / NXCD; wgid = (xcd < r ? xcd * (q + 1) : r * (q + 1) + (xcd - r) * q) + off; }
        const int nig = wgm * nN, gid = wgid / nig, fm = gid * wgm, gsz = (nM - fm) < wgm ? (nM - fm) : wgm;
        u.pm = fm + ((wgid % nig) % gsz); u.pn = (wgid % nig) / gsz; u.part = 0; return true;
    }
};
template <int ROWB_> struct SchedDenseT : Order {
    static constexpr bool GATHER = false; static constexpr int ROWB = ROWB_;
    const char* A; const char* B;
    __device__ __forceinline__ const char* a_tile(const Unit& u) const { return A + (size_t)u.pm * (BM * ROWB); }
    __device__ __forceinline__ const char* b_tile(const Unit& u) const { return B + (size_t)u.pn * (BM * ROWB); }
    __device__ __forceinline__ void a_offs(const Unit&, const int (&R)[2], const int (&C)[2], unsigned (&o)[2][2]) const {
#pragma unroll
        for (int h = 0; h < 2; ++h)
#pragma unroll
            for (int i = 0; i < 2; ++i) o[h][i] = (unsigned)((h * HALF + R[i]) * ROWB + C[i] * 2);
    }
};
typedef SchedDenseT<2048> SchedDense; typedef SchedDenseT<1024> SchedDense8;
struct SchedMoe1 : Order {
    static constexpr bool GATHER = true; static constexpr int ROWB = 1024;
    const char* A; const char* B; const int* rowtok; const LAS int* tile_e;
    __device__ __forceinline__ const char* a_tile(const Unit&) const { return A; }
    __device__ __forceinline__ const char* b_tile(const Unit& u) const { return B + ((size_t)__builtin_amdgcn_readfirstlane(tile_e[u.pm]) * 2048 + (size_t)u.pn * BM) * ROWB; }
    __device__ __forceinline__ void a_offs(const Unit& u, const int (&R)[2], const int (&C)[2], unsigned (&o)[2][2]) const {
#pragma unroll
        for (int h = 0; h < 2; ++h)
#pragma unroll
            for (int i = 0; i < 2; ++i) o[h][i] = (unsigned)(rowtok[u.pm * BM + h * HALF + R[i]] * ROWB + C[i] * 2);
    }
};
struct SchedMoe2 : Order {
    static constexpr bool GATHER = false; static constexpr int ROWB = 1024;
    const char* A; const char* B; const LAS int* tile_e;
    __device__ __forceinline__ const char* a_tile(const Unit& u) const { return A + (size_t)u.pm * (BM * ROWB); }
    __device__ __forceinline__ const char* b_tile(const Unit& u) const { return B + ((size_t)__builtin_amdgcn_readfirstlane(tile_e[u.pm]) * 1024 + (size_t)u.pn * BM) * ROWB; }
    __device__ __forceinline__ void a_offs(const Unit&, const int (&R)[2], const int (&C)[2], unsigned (&o)[2][2]) const {
#pragma unroll
        for (int h = 0; h < 2; ++h)
#pragma unroll
            for (int i = 0; i < 2; ++i) o[h][i] = (unsigned)((h * HALF + R[i]) * ROWB + C[i] * 2);
    }
};

struct BReg { u32x4 b[2]; };
struct TReg { u32x4 x[2][4][2]; float inv[2][4]; };
template <class E, class = void> struct has_tinit { static constexpr bool value = false; };
template <class E> struct has_tinit<E, decltype((void)E::TINIT)> { static constexpr bool value = E::TINIT; };
template <class E, class = void> struct has_binit { static constexpr bool value = false; };
template <class E> struct has_binit<E, decltype((void)E::BINIT)> { static constexpr bool value = E::BINIT; };
template <class E, class = void> struct keeps_acc { static constexpr bool value = false; };
template <class E> struct keeps_acc<E, decltype((void)E::KEEP)> { static constexpr bool value = E::KEEP; };
__device__ __forceinline__ void bias_init(f32x4 (&acc)[2][2][4][2], const BReg& r) {
#pragma unroll
    for (int bj = 0; bj < 2; ++bj) { const u32x4 bw = r.b[bj]; const f32x4 b0 = {bflo(bw.x), bfhi(bw.x), bflo(bw.y), bfhi(bw.y)}, b1 = {bflo(bw.z), bfhi(bw.z), bflo(bw.w), bfhi(bw.w)};
#pragma unroll
        for (int ai = 0; ai < 2; ++ai)
#pragma unroll
            for (int m = 0; m < 4; ++m) { acc[ai][bj][m][0] = b0; acc[ai][bj][m][1] = b1; } }
}
__device__ __forceinline__ void tile_init(f32x4 (&acc)[2][2][4][2], const TReg& t) {
#pragma unroll
    for (int ai = 0; ai < 2; ++ai)
#pragma unroll
        for (int m = 0; m < 4; ++m) { const float iv = __builtin_amdgcn_rcpf(t.inv[ai][m]);
#pragma unroll
            for (int bj = 0; bj < 2; ++bj) { const u32x4 xw = t.x[ai][m][bj];
                acc[ai][bj][m][0] = (f32x4){bflo(xw.x), bfhi(xw.x), bflo(xw.y), bfhi(xw.y)} * iv; acc[ai][bj][m][1] = (f32x4){bflo(xw.z), bfhi(xw.z), bflo(xw.w), bfhi(xw.w)} * iv; } }
}
template <class Epi, class Sched, bool ALIGN_EPI, bool SP2>
__device__ __forceinline__ void gemm_phase(LAS unsigned char* lds, const Sched& S, const Epi& E) {
    const int tid = threadIdx.x, wid = wave_id(), lane = tid & 63, wr = wid >> 2, wc = wid & 3, fr = lane & 15, fq = lane >> 4;
    constexpr int ROWB = Sched::ROWB, nt = ROWB / 128; constexpr bool FP8 = (ROWB == 1024);
    int Rr[2], Cc[2]; unsigned voffB[2];
#pragma unroll
    for (int i = 0; i < 2; ++i) { int R, C; stage_rc(tid * 16 + i * 8192, R, C); Rr[i] = R; Cc[i] = C; const int Rb = Epi::PERM ? ((R & ~31) + perm32(R & 31)) : R; voffB[i] = (unsigned)(Rb * ROWB + C * 2); }
    const size_t kstep = (size_t)(BK * 2);
    const size_t hstep = (size_t)HALF * ROWB;
    const unsigned ldsw = (unsigned)wid * 1024u;
    const int aoff = lds_byte(wr * 64 + fr, fq * 8), boff = lds_byte(wc * 32 + fr, fq * 8);
#define PG8_SA(b, h) (((b) * 2 + (h)) * HTB)
#define PG8_SB(b, h) ((4 + (b) * 2 + (h)) * HTB)
#define PG8_STAGE(bufoff, gbase, voff) do { _Pragma("unroll") for (int _i = 0; _i < 2; ++_i) \
        __builtin_amdgcn_global_load_lds((const unsigned*)((const char*)(gbase) + (voff)[_i]), (LAS unsigned*)(lds + (bufoff) + ldsw + _i * 8192), 16, 0, 0); } while (0)
#define PG8_LDA(dst, b, h) do { _Pragma("unroll") for (int m = 0; m < 4; ++m) { if constexpr (FP8) dst##8[m] = cat8(*(const LAS bf16x8*)(lds + PG8_SA(b, h) + aoff + m * 2048), *(const LAS bf16x8*)(lds + PG8_SA(b, h) + aoff + m * 2048 + 1024)); \
        else { _Pragma("unroll") for (int k = 0; k < 2; ++k) dst[m][k] = *(const LAS bf16x8*)(lds + PG8_SA(b, h) + aoff + m * 2048 + k * 1024); } } } while (0)
#define PG8_LDB(dst, b, h) do { _Pragma("unroll") for (int n = 0; n < 2; ++n) { if constexpr (FP8) dst##8[n] = cat8(*(const LAS bf16x8*)(lds + PG8_SB(b, h) + boff + n * 2048), *(const LAS bf16x8*)(lds + PG8_SB(b, h) + boff + n * 2048 + 1024)); \
        else { _Pragma("unroll") for (int k = 0; k < 2; ++k) dst[n][k] = *(const LAS bf16x8*)(lds + PG8_SB(b, h) + boff + n * 2048 + k * 1024); } } } while (0)
#define PG8_MMA(ai, bj, At, Bt) do { __builtin_amdgcn_s_setprio(1); _Pragma("unroll") for (int m = 0; m < 4; ++m) _Pragma("unroll") for (int n = 0; n < 2; ++n) { \
        if constexpr (FP8) asm volatile("s_nop 1\n\tv_mfma_scale_f32_16x16x128_f8f6f4 %0, %1, %2, %0, %3, %4 op_sel_hi:[0,0,0]" : "+v"(acc[ai][bj][m][n]) : "v"(Bt##8[n]), "v"(At##8[m]), "v"(sclW), "v"(sclX)); \
        else { _Pragma("unroll") for (int k = 0; k < 2; ++k) acc[ai][bj][m][n] = __builtin_amdgcn_mfma_f32_16x16x32_bf16(Bt[n][k], At[m][k], acc[ai][bj][m][n], 0, 0, 0); } } \
        __builtin_amdgcn_s_setprio(0); } while (0)
#define PG8_WAIT_V(n) asm volatile("s_waitcnt vmcnt(" #n ")" ::: "memory")
#define PG8_WAIT_L(n) asm volatile("s_waitcnt lgkmcnt(" #n ")" ::: "memory")
#define PG8_BAR __builtin_amdgcn_s_barrier()
#define PG8_SCHED __builtin_amdgcn_sched_barrier(0)
    Unit cur, nxt; int ui = 0;
    if (!S.next(0, cur)) return;
    f32x4 acc[2][2][4][2];
    constexpr bool BINIT = has_binit<Epi>::value;
    constexpr bool TINIT = has_tinit<Epi>::value;
    if constexpr (BINIT) { BReg br; E.bias_load(cur, wr, wc, fr, fq, br); bias_init(acc, br); }
    else if constexpr (TINIT) { TReg tr; E.tile_load(cur, wr, wc, fr, fq, tr); tile_init(acc, tr); }
    else {
#pragma unroll
    for (int a = 0; a < 2; ++a)
#pragma unroll
        for (int b = 0; b < 2; ++b)
#pragma unroll
            for (int m = 0; m < 4; ++m)
#pragma unroll
                for (int n = 0; n < 2; ++n) acc[a][b][m][n] = (f32x4){0.f, 0.f, 0.f, 0.f};
    }
    int sclW = 0x7A7A7A7A, sclX = 0x7F7F7F7F; asm volatile("" : "+v"(sclW), "+v"(sclX));
    bf16x8 At[4][2], B0[2][2], B1[2][2]; i32x8 At8[4], B08[2], B18[2]; (void)At; (void)B0; (void)B1; (void)At8; (void)B08; (void)B18;
    unsigned oC[2][2], oN[2][2]; typename Epi::Pre pre;
    S.a_offs(cur, Rr, Cc, oC);
    const char* cA = S.a_tile(cur); const char* cB = S.b_tile(cur);
    if constexpr (SP2) {
        PG8_STAGE(PG8_SB(0, 0), cB, voffB); PG8_STAGE(PG8_SB(0, 1), cB + hstep, voffB); PG8_STAGE(PG8_SA(0, 0), cA, oC[0]); PG8_STAGE(PG8_SA(0, 1), cA, oC[1]);
        if (wr == 1) PG8_BAR;
        PG8_WAIT_V(2); PG8_BAR;
        PG8_STAGE(PG8_SB(1, 0), cB + kstep, voffB); PG8_STAGE(PG8_SA(1, 0), cA + kstep, oC[0]); PG8_STAGE(PG8_SB(1, 1), cB + hstep + kstep, voffB);
        PG8_WAIT_V(6); PG8_BAR;
    } else {
        PG8_STAGE(PG8_SB(0, 0), cB, voffB); PG8_STAGE(PG8_SA(0, 0), cA, oC[0]); PG8_STAGE(PG8_SB(0, 1), cB + hstep, voffB); PG8_STAGE(PG8_SA(0, 1), cA, oC[1]);
        if (wr == 1) PG8_BAR;
        PG8_WAIT_V(4); PG8_BAR;
        PG8_STAGE(PG8_SB(1, 0), cB + kstep, voffB); PG8_STAGE(PG8_SA(1, 0), cA + kstep, oC[0]); PG8_STAGE(PG8_SB(1, 1), cB + hstep + kstep, voffB);
        PG8_WAIT_V(6); PG8_BAR;
    }
    for (;;) {
        const bool has_next = S.next(ui + 1, nxt);
        const char* nA = cA; const char* nB = cB;
        if (has_next) { nA = S.a_tile(nxt); nB = S.b_tile(nxt); if constexpr (Sched::GATHER) S.a_offs(nxt, Rr, Cc, oN); }
        else if constexpr (Sched::GATHER) {
#pragma unroll
            for (int h = 0; h < 2; ++h)
#pragma unroll
                for (int i = 0; i < 2; ++i) oN[h][i] = oC[h][i];
        }
#pragma nounroll
        for (int t = 0; t < nt; t += 2) {
            const bool last = (t == nt - 2);
            if (last) E.prefetch(cur, wr, wc, fr, fq, pre);
            const char* a1 = cA + (size_t)(t + 1) * kstep;
            const char* a2 = last ? nA : cA + (size_t)(t + 2) * kstep; const char* b2 = last ? nB : cB + (size_t)(t + 2) * kstep;
            const char* a3 = a2 + kstep; const char* b3 = b2 + kstep;
            unsigned o2[2][2];
#pragma unroll
            for (int h = 0; h < 2; ++h)
#pragma unroll
                for (int i = 0; i < 2; ++i) { if constexpr (Sched::GATHER) o2[h][i] = last ? oN[h][i] : oC[h][i]; else o2[h][i] = oC[h][i]; }
            if constexpr (SP2) {
            PG8_LDB(B0, 0, 0); PG8_LDB(B1, 0, 1); PG8_SCHED; PG8_LDA(At, 0, 0); PG8_STAGE(PG8_SA(1, 1), a1, oC[1]);
            PG8_WAIT_V(8); PG8_WAIT_L(0); PG8_BAR; PG8_MMA(0, 0, At, B0); PG8_MMA(0, 1, At, B1); PG8_BAR; PG8_SCHED;
            PG8_LDA(At, 0, 1); PG8_STAGE(PG8_SB(0, 0), b2, voffB); PG8_STAGE(PG8_SB(0, 1), b2 + hstep, voffB); PG8_STAGE(PG8_SA(0, 0), a2, o2[0]);
            PG8_WAIT_V(8); PG8_WAIT_L(0); PG8_BAR; PG8_MMA(1, 0, At, B0); PG8_MMA(1, 1, At, B1); PG8_BAR; PG8_SCHED;
            PG8_LDB(B0, 1, 0); PG8_LDB(B1, 1, 1); PG8_SCHED; PG8_LDA(At, 1, 0); PG8_STAGE(PG8_SA(0, 1), a2, o2[1]);
            PG8_WAIT_V(8); PG8_WAIT_L(0); PG8_BAR; PG8_MMA(0, 0, At, B0); PG8_MMA(0, 1, At, B1); PG8_BAR; PG8_SCHED;
            PG8_LDA(At, 1, 1); PG8_STAGE(PG8_SB(1, 0), b3, voffB); PG8_STAGE(PG8_SB(1, 1), b3 + hstep, voffB); PG8_STAGE(PG8_SA(1, 0), a3, o2[0]);
            PG8_WAIT_V(8); PG8_WAIT_L(0); PG8_BAR; PG8_MMA(1, 0, At, B0); PG8_MMA(1, 1, At, B1); PG8_BAR; PG8_SCHED;
            } else {
            PG8_LDB(B0, 0, 0); PG8_SCHED; PG8_LDA(At, 0, 0); PG8_STAGE(PG8_SA(1, 1), a1, oC[1]);
            PG8_WAIT_L(8); PG8_BAR; PG8_WAIT_L(0); PG8_MMA(0, 0, At, B0); PG8_BAR; PG8_SCHED;
            PG8_LDB(B1, 0, 1); PG8_STAGE(PG8_SB(0, 0), b2, voffB);
            PG8_BAR; PG8_WAIT_L(0); PG8_MMA(0, 1, At, B1); PG8_BAR;
            PG8_LDA(At, 0, 1); PG8_STAGE(PG8_SA(0, 0), a2, o2[0]);
            PG8_BAR; PG8_WAIT_L(0); PG8_MMA(1, 0, At, B0); PG8_BAR; PG8_SCHED;
            PG8_STAGE(PG8_SB(0, 1), b2 + hstep, voffB);
            PG8_WAIT_V(6); PG8_BAR; PG8_MMA(1, 1, At, B1); PG8_BAR;
            PG8_LDB(B0, 1, 0); PG8_SCHED; PG8_LDA(At, 1, 0); PG8_STAGE(PG8_SA(0, 1), a2, o2[1]);
            PG8_WAIT_L(8); PG8_BAR; PG8_WAIT_L(0); PG8_MMA(0, 0, At, B0); PG8_BAR; PG8_SCHED;
            PG8_LDB(B1, 1, 1); PG8_STAGE(PG8_SB(1, 0), b3, voffB);
            PG8_BAR; PG8_WAIT_L(0); PG8_MMA(0, 1, At, B1); PG8_BAR;
            PG8_LDA(At, 1, 1); PG8_STAGE(PG8_SA(1, 0), a3, o2[0]);
            PG8_BAR; PG8_WAIT_L(0); PG8_MMA(1, 0, At, B0); PG8_BAR; PG8_SCHED;
            PG8_STAGE(PG8_SB(1, 1), b3 + hstep, voffB);
            PG8_WAIT_V(6); PG8_BAR; PG8_MMA(1, 1, At, B1); PG8_BAR;
            }
        }
        if constexpr (ALIGN_EPI) { if (wr == 0) PG8_BAR; }
        BReg br; (void)br;
        if constexpr (BINIT) E.bias_load(has_next ? nxt : cur, wr, wc, fr, fq, br);
        if constexpr (FP8) asm volatile("s_nop 15\n\ts_nop 15" ::: "memory");
        E(acc, cur, wr, wc, fr, fq, pre);
        if (!has_next) break;
        if constexpr (BINIT) bias_init(acc, br);
        else if constexpr (TINIT) { TReg tr; E.tile_load(nxt, wr, wc, fr, fq, tr); tile_init(acc, tr); }
        else if (!(keeps_acc<Epi>::value && cur.part == 0)) {
#pragma unroll
        for (int a = 0; a < 2; ++a)
#pragma unroll
            for (int b = 0; b < 2; ++b)
#pragma unroll
                for (int m = 0; m < 4; ++m)
#pragma unroll
                    for (int n = 0; n < 2; ++n) acc[a][b][m][n] = (f32x4){0.f, 0.f, 0.f, 0.f};
        }
        cur = nxt; cA = nA; cB = nB; ++ui;
        if constexpr (Sched::GATHER) {
#pragma unroll
        for (int h = 0; h < 2; ++h)
#pragma unroll
            for (int i = 0; i < 2; ++i) oC[h][i] = oN[h][i]; }
        if constexpr (ALIGN_EPI) { if (wr == 1) PG8_BAR; }
    }
    PG8_WAIT_V(0);
    if constexpr (!ALIGN_EPI) { if (wr == 0) PG8_BAR; }
    PG8_BAR;
#undef PG8_SA
#undef PG8_SB
#undef PG8_STAGE
#undef PG8_LDA
#undef PG8_LDB
#undef PG8_MMA
#undef PG8_WAIT_V
#undef PG8_WAIT_L
#undef PG8_BAR
#undef PG8_SCHED
}

typedef f32x4 Acc[2][2][4][2];
__device__ __forceinline__ u32x4 widen16(u32x2 xa, u32x2 xb) {
    const auto r0 = __builtin_amdgcn_permlane16_swap(xa.x, xb.x, false, false), r1 = __builtin_amdgcn_permlane16_swap(xa.y, xb.y, false, false);
    return (u32x4){r0[0], r1[0], r0[1], r1[1]};
}
struct NoPre {};
struct EpiInProj {
    typedef NoPre Pre; __device__ __forceinline__ void prefetch(const Unit&, int, int, int, int, Pre&) const {}
    static constexpr bool PERM = true;
    bf16_t* slots; const float* rs1; float* out; int seg;
    __device__ __forceinline__ void operator()(Acc& acc, const Unit& u, int wr, int wc, int fr, int fq, const Pre& pre) const {
        const int pn = u.pn, row0 = u.pm * BM + wr * 64 + fr;
        const bool ptile = (pn >= 16 && pn < 20) || (pn >= 24 && pn < 28), gtile = pn >= 28;
        if (ptile) {
            const int q = pn < 20 ? pn - 16 : pn - 20, col0 = q * HALF + wc * 32 + 8 * fq;
            bf16_t* base = slots + (size_t)4 * ((size_t)MS * D);
#pragma unroll
            for (int ai = 0; ai < 2; ++ai)
#pragma unroll
                for (int m = 0; m < 4; ++m) { const f32x4 v0 = acc[ai][0][m][0] * acc[ai][1][m][0], v1 = acc[ai][0][m][1] * acc[ai][1][m][1];
                    u32x4 w; w.x = cvt_pk_bf16(v0[0], v0[1]); w.y = cvt_pk_bf16(v0[2], v0[3]); w.z = cvt_pk_bf16(v1[0], v1[1]); w.w = cvt_pk_bf16(v1[2], v1[3]);
                    *(u32x4*)(base + (size_t)(row0 + ai * HALF + m * 16) * D + col0) = w; }
        } else if (gtile) {
            const int col0 = (pn - 28) * HALF + wc * 32 + 8 * fq;
            bf16_t* bA = slots + (size_t)7 * ((size_t)MS * D); bf16_t* bB = slots + (size_t)8 * ((size_t)MS * D);
#pragma unroll
            for (int ai = 0; ai < 2; ++ai)
#pragma unroll
                for (int m = 0; m < 4; ++m) { const size_t off = (size_t)(row0 + ai * HALF + m * 16) * D + col0;
                    f32x4 r0, r1, b0, b1;
#pragma unroll
                    for (int j = 0; j < 4; ++j) { b0[j] = sigmoidf_(acc[ai][1][m][0][j]); b1[j] = sigmoidf_(acc[ai][1][m][1][j]);
                        r0[j] = sigmoidf_(acc[ai][0][m][0][j]) * __builtin_amdgcn_rcpf(1e-20f + b0[j]); r1[j] = sigmoidf_(acc[ai][0][m][1][j]) * __builtin_amdgcn_rcpf(1e-20f + b1[j]); }
                    u32x4 w; w.x = cvt_pk_bf16(r0[0], r0[1]); w.y = cvt_pk_bf16(r0[2], r0[3]); w.z = cvt_pk_bf16(r1[0], r1[1]); w.w = cvt_pk_bf16(r1[2], r1[3]);
                    *(u32x4*)(bA + off) = w;
                    w.x = cvt_pk_bf16(b0[0], b0[1]); w.y = cvt_pk_bf16(b0[2], b0[3]); w.z = cvt_pk_bf16(b1[0], b1[1]); w.w = cvt_pk_bf16(b1[2], b1[3]);
                    *(u32x4*)(bB + off) = w; }
        } else {
            const int arr = pn >> 2, col0 = (pn & 3) * BM + wc * 32 + 8 * fq; const bool tod = arr == 5;
            bf16_t* base = slots + (size_t)arr * ((size_t)MS * D);
#pragma unroll
            for (int ai = 0; ai < 2; ++ai)
#pragma unroll
                for (int m = 0; m < 4; ++m) { const int row = row0 + ai * HALF + m * 16; bf16_t* rowp = tod ? (bf16_t*)out + (size_t)grow(seg, row) * (2 * D) + col0 : base + (size_t)row * D + col0;
#pragma unroll
                    for (int bj = 0; bj < 2; ++bj) { const f32x4 v0 = acc[ai][bj][m][0], v1 = acc[ai][bj][m][1];
                        u32x4 w; w.x = cvt_pk_bf16(v0[0], v0[1]); w.y = cvt_pk_bf16(v0[2], v0[3]); w.z = cvt_pk_bf16(v1[0], v1[1]); w.w = cvt_pk_bf16(v1[2], v1[3]);
                        *(u32x4*)(rowp + bj * HALF) = w; } }
        }
    }
};
struct SchedMerge : Order {
    static constexpr bool GATHER = false; static constexpr int ROWB = 1024;
    const char* A0; const char* B0; const char* A1; const char* B1;
    __device__ __forceinline__ bool next(int i, Unit& u) const { const bool ok = Order::next(i >> 1, u); u.part = i & 1; return ok; }
    __device__ __forceinline__ const char* a_tile(const Unit& u) const { return (u.part ? A1 : A0) + (size_t)u.pm * (BM * ROWB); }
    __device__ __forceinline__ const char* b_tile(const Unit& u) const { return (u.part ? B1 : B0) + (size_t)u.pn * (BM * ROWB); }
    __device__ __forceinline__ void a_offs(const Unit&, const int (&R)[2], const int (&C)[2], unsigned (&o)[2][2]) const {
#pragma unroll
        for (int h = 0; h < 2; ++h)
#pragma unroll
            for (int i = 0; i < 2; ++i) o[h][i] = (unsigned)((h * HALF + R[i]) * ROWB + C[i] * 2);
    }
};
struct EpiMerge {
    typedef NoPre Pre; __device__ __forceinline__ void prefetch(const Unit&, int, int, int, int, Pre&) const {}
    static constexpr bool PERM = true, KEEP = true;
    bf16_t* out; const bf16_t* gA; const bf16_t* gB;
    __device__ __forceinline__ void operator()(Acc& acc, const Unit& u, int wr, int wc, int fr, int fq, const Pre&) const {
        const int col0 = u.pn * BM + wc * 32 + 8 * fq, row0 = u.pm * BM + wr * 64 + fr;
        if (u.part == 0) {
#pragma unroll
            for (int ai = 0; ai < 2; ++ai)
#pragma unroll
                for (int m = 0; m < 4; ++m) { const size_t off = (size_t)(row0 + ai * HALF + m * 16) * D + col0;
#pragma unroll
                    for (int bj = 0; bj < 2; ++bj) { const u32x4 a = *(const u32x4*)(gA + off + bj * HALF);
                        f32x4& v0 = acc[ai][bj][m][0]; f32x4& v1 = acc[ai][bj][m][1];
                        v0[0] *= bflo(a.x); v0[1] *= bfhi(a.x); v0[2] *= bflo(a.y); v0[3] *= bfhi(a.y); v1[0] *= bflo(a.z); v1[1] *= bfhi(a.z); v1[2] *= bflo(a.w); v1[3] *= bfhi(a.w); }
                    if (m & 1) asm volatile("" ::: "memory"); }
        } else {
#pragma unroll
            for (int ai = 0; ai < 2; ++ai)
#pragma unroll
                for (int m = 0; m < 4; ++m) { const size_t off = (size_t)(row0 + ai * HALF + m * 16) * D + col0;
#pragma unroll
                    for (int bj = 0; bj < 2; ++bj) { const u32x4 g = *(const u32x4*)(gB + off + bj * HALF);
                        f32x4 v0 = acc[ai][bj][m][0], v1 = acc[ai][bj][m][1];
                        v0[0] *= bflo(g.x); v0[1] *= bfhi(g.x); v0[2] *= bflo(g.y); v0[3] *= bfhi(g.y); v1[0] *= bflo(g.z); v1[1] *= bfhi(g.z); v1[2] *= bflo(g.w); v1[3] *= bfhi(g.w);
                        u32x4 w; w.x = cvt_pk_bf16(v0[0], v0[1]); w.y = cvt_pk_bf16(v0[2], v0[3]); w.z = cvt_pk_bf16(v1[0], v1[1]); w.w = cvt_pk_bf16(v1[2], v1[3]);
                        *(u32x4*)(out + off + bj * HALF) = w; }
                    if (m & 1) asm volatile("" ::: "memory"); }
        }
    }
};
struct EpiMix {
    typedef NoPre Pre; __device__ __forceinline__ void prefetch(const Unit&, int, int, int, int, Pre&) const {}
    static constexpr bool PERM = true, TINIT = true;
    const bf16_t* xb; const float* rs1; float* out; int seg;
    __device__ __forceinline__ void tile_load(const Unit& u, int wr, int wc, int fr, int fq, TReg& t) const {
        const int col0 = u.pn * BM + wc * 32 + 8 * fq, row0 = u.pm * BM + wr * 64 + fr;
#pragma unroll
        for (int ai = 0; ai < 2; ++ai)
#pragma unroll
            for (int m = 0; m < 4; ++m) { const int row = row0 + ai * HALF + m * 16; t.inv[ai][m] = rs1[row];
#pragma unroll
                for (int bj = 0; bj < 2; ++bj) t.x[ai][m][bj] = *(const u32x4*)(xb + (size_t)row * D + col0 + bj * HALF); }
    }
    __device__ __forceinline__ void operator()(Acc& acc, const Unit& u, int wr, int wc, int fr, int fq, const Pre& pre) const {
        const int col0 = u.pn * BM + wc * 32 + 8 * fq, row0 = u.pm * BM + wr * 64 + fr;
#pragma unroll
        for (int ai = 0; ai < 2; ++ai)
#pragma unroll
            for (int m = 0; m < 4; ++m) { const int row = row0 + ai * HALF + m * 16; bf16_t* hr = (bf16_t*)out + (size_t)grow(seg, row) * (2 * D) + col0;
#pragma unroll
                for (int bj = 0; bj < 2; ++bj) { const f32x4 v0 = acc[ai][bj][m][0], v1 = acc[ai][bj][m][1];
                    u32x4 w; w.x = cvt_pk_bf16(v0[0], v0[1]); w.y = cvt_pk_bf16(v0[2], v0[3]); w.z = cvt_pk_bf16(v1[0], v1[1]); w.w = cvt_pk_bf16(v1[2], v1[3]);
                    *(u32x4*)(hr + bj * HALF) = w; } }
    }
};
struct EpiMoe1 {
    typedef NoPre Pre; __device__ __forceinline__ void prefetch(const Unit&, int, int, int, int, Pre&) const {}
    static constexpr bool PERM = true, BINIT = true;
    unsigned char* hid; const LAS int* tile_e; const bf16_t* bgu;
    __device__ __forceinline__ void bias_load(const Unit& u, int wr, int wc, int fr, int fq, BReg& r) const {
        const int e = __builtin_amdgcn_readfirstlane(tile_e[u.pm]); const bf16_t* bgp = bgu + (size_t)e * 2048 + u.pn * HALF + wc * 32 + 8 * fq;
        r.b[0] = *(const u32x4*)bgp; r.b[1] = *(const u32x4*)(bgp + 1024);
    }
    __device__ __forceinline__ void operator()(Acc& acc, const Unit& u, int wr, int wc, int fr, int fq, const Pre&) const {
        const int row0 = u.pm * BM + wr * 64 + fr;
#pragma unroll
        for (int ai = 0; ai < 2; ++ai) { u32x2 w[4];
#pragma unroll
            for (int m = 0; m < 4; ++m) {
                const f32x4 g0 = acc[ai][0][m][0], g1 = acc[ai][0][m][1], u0 = acc[ai][1][m][0], u1 = acc[ai][1][m][1];
                f32x4 h0, h1;
#pragma unroll
                for (int j = 0; j < 4; ++j) {
                    const float ga = fminf(g0[j], 7.0f), gb = fminf(g1[j], 7.0f);
                    const float ua = __builtin_amdgcn_fmed3f(u0[j], -7.0f, 7.0f), ub = __builtin_amdgcn_fmed3f(u1[j], -7.0f, 7.0f);
                    h0[j] = __builtin_fmaf(ua, ga, ga) * __builtin_amdgcn_rcpf(1.0f + __builtin_amdgcn_exp2f(ga * -2.45546696f));
                    h1[j] = __builtin_fmaf(ub, gb, gb) * __builtin_amdgcn_rcpf(1.0f + __builtin_amdgcn_exp2f(gb * -2.45546696f)); }
                w[m].x = cvt_pk4_fp8(h0[0], h0[1], h0[2], h0[3]); w[m].y = cvt_pk4_fp8(h1[0], h1[1], h1[2], h1[3]); }
#pragma unroll
            for (int mp = 0; mp < 2; ++mp) *(u32x4*)(hid + (size_t)(row0 + 16 * (fq & 1) + ai * HALF + mp * 32) * D + u.pn * HALF + wc * 32 + 8 * (fq & 2)) = widen16(w[2 * mp], w[2 * mp + 1]); }
    }
};
struct EpiMoe2 {
    typedef NoPre Pre; __device__ __forceinline__ void prefetch(const Unit&, int, int, int, int, Pre&) const {}
    static constexpr bool PERM = true, BINIT = true;
    unsigned char* y; const LAS int* tile_e; const bf16_t* bdn;
    __device__ __forceinline__ void bias_load(const Unit& u, int wr, int wc, int fr, int fq, BReg& r) const {
        const int e = __builtin_amdgcn_readfirstlane(tile_e[u.pm]); const int col0 = u.pn * BM + wc * 32 + 8 * fq;
#pragma unroll
        for (int bj = 0; bj < 2; ++bj) r.b[bj] = *(const u32x4*)(bdn + (size_t)e * D + col0 + bj * HALF);
    }
    __device__ __forceinline__ void operator()(Acc& acc, const Unit& u, int wr, int wc, int fr, int fq, const Pre&) const {
        const int colw = u.pn * BM + wc * 32 + 8 * (fq & 2), row0 = u.pm * BM + wr * 64 + fr + 16 * (fq & 1);
#pragma unroll
        for (int ai = 0; ai < 2; ++ai)
#pragma unroll
            for (int bj = 0; bj < 2; ++bj) { u32x2 w[4];
#pragma unroll
                for (int m = 0; m < 4; ++m) { const f32x4 v0 = acc[ai][bj][m][0], v1 = acc[ai][bj][m][1]; w[m].x = cvt_pk4_fp8(v0[0], v0[1], v0[2], v0[3]); w[m].y = cvt_pk4_fp8(v1[0], v1[1], v1[2], v1[3]); }
#pragma unroll
                for (int mp = 0; mp < 2; ++mp) *(u32x4*)(y + (size_t)(row0 + ai * HALF + mp * 32) * D + colw + bj * HALF) = widen16(w[2 * mp], w[2 * mp + 1]); }
    }
};
}

#ifndef PG8_SP2
#define PG8_SP2 true
#endif
#ifndef PG8_ALIGN
#define PG8_ALIGN true
#endif

struct Args { const float* in[19]; float* out; unsigned char* ws; int do_pro, seg_lo, seg_hi, ph_lo, ph_hi, pad; };
enum { I_X = 0, I_NMG, I_WIN, I_CONVW, I_ALOG, I_DTB, I_GNG, I_WOG, I_SCW, I_WOS, I_WMX, I_NFG, I_WR, I_BR, I_WGU, I_BGU, I_WDN, I_BDN, I_NFIN };

typedef const __attribute__((address_space(4))) Args* KArgsP;
__device__ __forceinline__ Args load_args() {
#if defined(__HIP_DEVICE_COMPILE__)
    KArgsP p = (KArgsP)__builtin_amdgcn_kernarg_segment_ptr(); asm volatile("" : "+s"(p)); return *p;
#else
    return Args{};
#endif
}
__device__ __forceinline__ void tr_item(const float* __restrict__ src, int ld, int c0, const float* __restrict__ scale, bf16_t* dst, int k0, LAS float* scr, int lane) {
#pragma unroll 8
    for (int i = 0; i < 32; ++i) { const int kk = 2 * i + (lane >> 5); float v = src[(size_t)(k0 + kk) * ld + c0 + (lane & 31)]; if (scale) v *= scale[k0 + kk]; scr[kk * 33 + (lane & 31)] = v; }
    LDS_WAIT();
    const int c = lane & 7;
#pragma unroll
    for (int j = 0; j < 4; ++j) { const int n = (lane >> 3) + 8 * j; const LAS float* s = scr + (8 * c) * 33 + n;
        u32x4 o; o.x = cvt_pk_bf16(s[0 * 33], s[1 * 33]); o.y = cvt_pk_bf16(s[2 * 33], s[3 * 33]); o.z = cvt_pk_bf16(s[4 * 33], s[5 * 33]); o.w = cvt_pk_bf16(s[6 * 33], s[7 * 33]);
        *(u32x4*)(dst + (size_t)n * 1024 + k0 + 8 * c) = o; }
    LDS_WAIT();
}
template <bool FP8OUT>
__device__ __forceinline__ void tr_item64(const float* __restrict__ src, int ld, int c0, const float* __restrict__ scale, float mul, unsigned char* dst, int k0, LAS float* scr, int lane) {
    const int nl = (lane & 15) * 4, kl = lane >> 4;
    f32x4 v[8];
#pragma unroll
    for (int i = 0; i < 8; ++i) v[i] = *(const f32x4*)(src + (size_t)(k0 + 4 * i + kl) * ld + c0 + nl);
#pragma unroll
    for (int i = 0; i < 8; ++i) { const int kk = 4 * i + kl; const float sc = scale ? scale[k0 + kk] * mul : mul;
#pragma unroll
        for (int j = 0; j < 4; ++j) scr[kk * 65 + nl + j] = v[i][j] * sc; }
    LDS_WAIT();
#pragma unroll
    for (int t = 0; t < 4; ++t) { const int task = t * 64 + lane, n = task >> 2, c = task & 3; const LAS float* sp = scr + (8 * c) * 65 + n;
        if constexpr (FP8OUT) { u32x2 o; o.x = cvt_pk4_fp8(sp[0], sp[65], sp[130], sp[195]); o.y = cvt_pk4_fp8(sp[260], sp[325], sp[390], sp[455]); *(u32x2*)(dst + (size_t)n * 1024 + k0 + 8 * c) = o; }
        else { u32x4 o; o.x = cvt_pk_bf16(sp[0], sp[65]); o.y = cvt_pk_bf16(sp[130], sp[195]); o.z = cvt_pk_bf16(sp[260], sp[325]); o.w = cvt_pk_bf16(sp[390], sp[455]); *(u32x4*)(dst + (size_t)n * 2048 + (k0 + 8 * c) * 2) = o; } }
    LDS_WAIT();
}
template <int NSUB>
__device__ __forceinline__ void tr_run64_fp8(const float* __restrict__ src, int ld, int c0, const float* __restrict__ scale, float mul, unsigned char* dst, int k0, LAS float* scr, int lane) {
    const int nl = (lane & 15) * 4, kl = lane >> 4;
    const float* p = src + (size_t)(k0 + kl) * ld + c0 + nl;
    f32x4 v[8];
#pragma unroll
    for (int i = 0; i < 8; ++i) v[i] = *(const f32x4*)(p + (size_t)(4 * i) * ld);
#pragma unroll
    for (int sb = 0; sb < NSUB; ++sb) {
        const int kb = k0 + 32 * sb;
#pragma unroll
        for (int i = 0; i < 8; ++i) { const int kk = 4 * i + kl; const float sc = scale ? scale[kb + kk] * mul : mul;
#pragma unroll
            for (int j = 0; j < 4; ++j) scr[kk * 65 + nl + j] = v[i][j] * sc; }
        if (sb + 1 < NSUB) {
#pragma unroll
            for (int i = 0; i < 8; ++i) v[i] = *(const f32x4*)(p + (size_t)(32 * (sb + 1) + 4 * i) * ld); }
        LDS_WAIT();
#pragma unroll
        for (int t = 0; t < 2; ++t) { const int task = t * 64 + lane, n = task >> 1, c = task & 1; const LAS float* sp = scr + (16 * c) * 65 + n;
            u32x4 o; o.x = cvt_pk4_fp8(sp[0], sp[65], sp[130], sp[195]); o.y = cvt_pk4_fp8(sp[260], sp[325], sp[390], sp[455]);
            o.z = cvt_pk4_fp8(sp[520], sp[585], sp[650], sp[715]); o.w = cvt_pk4_fp8(sp[780], sp[845], sp[910], sp[975]);
            *(u32x4*)(dst + (size_t)n * 1024 + kb + 16 * c) = o; }
        LDS_WAIT();
    }
}
__device__ __forceinline__ void phase_prep(const Args& a, LAS unsigned char* lds) {
    const int wave = wave_id(), lane = threadIdx.x & 63;
    LAS float* scr = (LAS float*)(lds + wave * 8448);
    unsigned char* ws = a.ws;
    constexpr int I_IN = 32 * 144, I_SQ = 32 * 16, U_GU = 32 * 8 * 32, U_DN = 32 * 8 * 16, I_AB = 16, I_R = 16;
    constexpr int NIT = I_IN + 3 * I_SQ + I_AB + I_R;
    const int gw = blockIdx.x * 8 + wave, NGW = gridDim.x * 8;
    for (int i = gw * 64 + lane; i < NE * 2048 / 2; i += NGW * 64) ((unsigned*)(ws + WS_BGU16))[i] = cvt_pk_bf16(a.in[I_BGU][2 * i], a.in[I_BGU][2 * i + 1]);
    for (int i = gw * 64 + lane; i < NE * 1024 / 2; i += NGW * 64) ((unsigned*)(ws + WS_BDN16))[i] = cvt_pk_bf16(a.in[I_BDN][2 * i], a.in[I_BDN][2 * i + 1]);
    for (int u = gw; u < U_GU + U_DN; u += NGW) {
        if (u < U_GU) { const int e = u >> 8, kq = (u >> 5) & 7, nb = u & 31, n0 = nb * 64, pn = n0 >> 8, bj = (n0 >> 7) & 1, j0 = n0 & 127, c0 = bj * 1024 + pn * 128 + j0;
            tr_run64_fp8<4>(a.in[I_WGU] + (size_t)e * 1024 * 2048, 2048, c0, a.in[I_NFG], 32.0f, ws + WS_WGU + ((size_t)e * 2048 + n0) * 1024, kq * 128, scr, lane); }
        else { const int r = u - U_GU, e = r >> 7, kq = (r >> 4) & 7, nb = r & 15;
            tr_run64_fp8<4>(a.in[I_WDN] + (size_t)e * 1024 * 1024, 1024, nb * 64, nullptr, 32.0f, ws + WS_WDN + ((size_t)e * 1024 + nb * 64) * 1024, kq * 128, scr, lane); }
    }
    for (int it = gw; it < NIT; it += NGW) {
        int r = it;
        if (r < I_IN) { const int kb = r / 144, nb = r % 144, n0 = nb * 64;
            int lc = n0; { const int pn = n0 >> 8, hf = (n0 >> 7) & 1, j = n0 & 127;
                if ((pn >= 16 && pn < 20) || (pn >= 24 && pn < 28)) lc = (hf ? 6 : 4) * 1024 + (pn < 20 ? pn - 16 : pn - 20) * 128 + j;
                else if (pn >= 28) lc = (hf ? 8 : 7) * 1024 + (pn - 28) * 128 + j; }
            const int c0 = lc < 4096 ? lc : lc + 16;
            tr_item64<false>(a.in[I_WIN], DIN, c0, a.in[I_NMG], 1.0f, ws + WS_WIN + (size_t)n0 * 2048, kb * 32, scr, lane); continue; } r -= I_IN;
        if (r < I_SQ) { const int kb = r >> 4, nb = r & 15; tr_item64<true>(a.in[I_WOG], 1024, nb * 64, nullptr, 32.0f, ws + WS_WOG + (size_t)nb * 64 * 1024, kb * 32, scr, lane); continue; } r -= I_SQ;
        if (r < I_SQ) { const int kb = r >> 4, nb = r & 15; tr_item64<true>(a.in[I_WOS], 1024, nb * 64, nullptr, 32.0f, ws + WS_WOS + (size_t)nb * 64 * 1024, kb * 32, scr, lane); continue; } r -= I_SQ;
        if (r < I_SQ) { const int kb = r >> 4, nb = r & 15; tr_item64<false>(a.in[I_WMX], 1024, nb * 64, nullptr, 1.0f, ws + WS_WMX + (size_t)nb * 64 * 2048, kb * 32, scr, lane); continue; } r -= I_SQ;
        if (r < I_AB) { tr_item(a.in[I_WIN], DIN, 4096, a.in[I_NMG], (bf16_t*)(ws + WS_WAB), r * 64, scr, lane); continue; } r -= I_AB;
        tr_item(a.in[I_WR], 32, 0, a.in[I_NFG], (bf16_t*)(ws + WS_WR), r * 64, scr, lane);
    }
}

__device__ __forceinline__ void phase_cast(const Args& a, int seg) {
    const int wave = wave_id(), lane = threadIdx.x & 63;
    unsigned char* ws = a.ws;
    const float* x = a.in[I_X]; bf16_t* xb = (bf16_t*)(ws + WS_SLOTS + 9 * SLOT); const bf16_t* wab = (const bf16_t*)(ws + WS_WAB);
    float* rs1 = (float*)(ws + WS_RS1); float* gb = (float*)(ws + WS_GB);
    const int gw = blockIdx.x * 8 + wave, NGW = gridDim.x * 8, tk = lane & 15, quad = lane >> 4;
    for (int grp = gw; grp < MS / 16; grp += NGW) {
        const int r = grp * 16 + tk; const int Rg = grow(seg, r);
        const float* xr = x + (size_t)Rg * D + quad * 8; bf16_t* xo = xb + (size_t)r * D + quad * 8; const bf16_t* wr_ = wab + (size_t)tk * D + quad * 8;
        f32x4 acc = {0.f, 0.f, 0.f, 0.f}; float ss = 0.f;
        u32x4 keep[32];
#pragma unroll
        for (int ks = 0; ks < 32; ++ks) {
            const f32x4 v0 = *(const f32x4*)(xr + ks * 32), v1 = *(const f32x4*)(xr + ks * 32 + 4);
            ss += (v0[0] * v0[0] + v0[1] * v0[1]) + (v0[2] * v0[2] + v0[3] * v0[3]) + (v1[0] * v1[0] + v1[1] * v1[1]) + (v1[2] * v1[2] + v1[3] * v1[3]);
            keep[ks].x = cvt_pk_bf16(v0[0], v0[1]); keep[ks].y = cvt_pk_bf16(v0[2], v0[3]); keep[ks].z = cvt_pk_bf16(v1[0], v1[1]); keep[ks].w = cvt_pk_bf16(v1[2], v1[3]);
        }
        ss += __shfl_xor(ss, 16); ss += __shfl_xor(ss, 32);
        const float rs = 1.0f / sqrtf(ss * (1.0f / D) + EPS);
#pragma unroll
        for (int ks = 0; ks < 32; ++ks) {
            const u32x4 k = keep[ks];
            u32x4 p; p.x = cvt_pk_bf16(bflo(k.x) * rs, bfhi(k.x) * rs); p.y = cvt_pk_bf16(bflo(k.y) * rs, bfhi(k.y) * rs); p.z = cvt_pk_bf16(bflo(k.z) * rs, bfhi(k.z) * rs); p.w = cvt_pk_bf16(bflo(k.w) * rs, bfhi(k.w) * rs);
            *(u32x4*)(xo + ks * 32) = p;
            const bf16x8 wf = *(const bf16x8*)(wr_ + ks * 32);
            acc = __builtin_amdgcn_mfma_f32_16x16x32_bf16(wf, __builtin_bit_cast(bf16x8, p), acc, 0, 0, 0);
        }
        f32x4 o;
#pragma unroll
        for (int j = 0; j < 4; ++j) {
            const int n = quad * 4 + j; const float v = acc[j];
            if (quad < 2) { const float t = v + a.in[I_DTB][n]; const float sp = t > 20.f ? t : log1pf(expf(t)); o[j] = -expf(a.in[I_ALOG][n]) * sp; }
            else o[j] = 1.0f / (1.0f + expf(-v));
        }
        *(f32x4*)(gb + (size_t)r * 16 + quad * 4) = o;
        if (quad == 0) rs1[r] = rs;
    }
}

__device__ __forceinline__ void ld8(const bf16_t* p, float (&v)[8]) { const u32x4 w = *(const u32x4*)p; v[0] = bflo(w.x); v[1] = bfhi(w.x); v[2] = bflo(w.y); v[3] = bfhi(w.y); v[4] = bflo(w.z); v[5] = bfhi(w.z); v[6] = bflo(w.w); v[7] = bfhi(w.w); }
__device__ __forceinline__ void st8(bf16_t* p, const float (&v)[8]) { u32x4 w; w.x = cvt_pk_bf16(v[0], v[1]); w.y = cvt_pk_bf16(v[2], v[3]); w.z = cvt_pk_bf16(v[4], v[5]); w.w = cvt_pk_bf16(v[6], v[7]); *(u32x4*)p = w; }
__device__ __forceinline__ void st8_fp8(unsigned char* p, const float (&v)[8]) { u32x2 w; w.x = cvt_pk4_fp8(sat8(v[0]), sat8(v[1]), sat8(v[2]), sat8(v[3])); w.y = cvt_pk4_fp8(sat8(v[4]), sat8(v[5]), sat8(v[6]), sat8(v[7])); *(u32x2*)p = w; }
__device__ __forceinline__ void ldf8(const float* p, float (&v)[8]) { const f32x4 a = *(const f32x4*)p, b = *(const f32x4*)(p + 4); v[0] = a[0]; v[1] = a[1]; v[2] = a[2]; v[3] = a[3]; v[4] = b[0]; v[5] = b[1]; v[6] = b[2]; v[7] = b[3]; }
__device__ __forceinline__ void up8(const u32x4 w, float (&v)[8]) { v[0] = bflo(w.x); v[1] = bfhi(w.x); v[2] = bflo(w.y); v[3] = bfhi(w.y); v[4] = bflo(w.z); v[5] = bfhi(w.z); v[6] = bflo(w.w); v[7] = bfhi(w.w); }
constexpr int TBK = 32;
__device__ __forceinline__ void phase_sconv(const Args& a, int seg) {
    const int wave = wave_id(), lane = threadIdx.x & 63;
    unsigned char* ws = a.ws;
    const bf16_t* PS = (const bf16_t*)(ws + WS_SLOTS + 4 * SLOT); const bf16_t* Bg = (const bf16_t*)a.out;
    unsigned char* U = ws + WS_SLOTS + 10 * SLOT; bf16_t* halo = (bf16_t*)(ws + WS_HALOS);
    const int gw = blockIdx.x * 8 + wave, NGW = gridDim.x * 8;
    constexpr int NTB = L / TBK, NU = NB * NTB * 2;
    for (int un = gw; un < NU; un += NGW) {
        const int sl = un & 1, tb = (un >> 1) % NTB, b = (un >> 1) / NTB, ch = sl * 512 + lane * 8, tl0 = tb * TBK;
        float w0[8], w1[8], w2[8]; ldf8(a.in[I_SCW] + ch, w0); ldf8(a.in[I_SCW] + 1024 + ch, w1); ldf8(a.in[I_SCW] + 2048 + ch, w2);
        float p2[8], p1[8];
        if (tl0 > 0) { const size_t o2 = (size_t)(b * L + tl0 - 2) * D + ch; ld8(PS + o2, p2); ld8(PS + o2 + D, p1); }
        else if (seg > 0) { const bf16_t* hp = halo + ((size_t)(((seg - 1) & 1) * 16 + b) * 2) * 1024 + ch; ld8(hp, p2); ld8(hp + 1024, p1); }
        else {
#pragma unroll
            for (int i = 0; i < 8; ++i) { p2[i] = 0.f; p1[i] = 0.f; } }
#pragma unroll 1
        for (int t0 = 0; t0 < TBK; t0 += 4) {
            u32x4 pw[4], bw[4];
#pragma unroll
            for (int q = 0; q < 4; ++q) { const size_t o = (size_t)(b * L + tl0 + t0 + q) * D + ch; pw[q] = *(const u32x4*)(PS + o); bw[q] = *(const u32x4*)(Bg + (size_t)grow(seg, b * L + tl0 + t0 + q) * (2 * D) + ch); }
#pragma unroll
            for (int q = 0; q < 4; ++q) { const size_t o = (size_t)(b * L + tl0 + t0 + q) * D + ch; float pa[8], ba[8], r[8]; up8(pw[q], pa); up8(bw[q], ba);
#pragma unroll
                for (int i = 0; i < 8; ++i) { const float p = pa[i]; r[i] = ba[i] * (w0[i] * p2[i] + w1[i] * p1[i] + w2[i] * p); p2[i] = p1[i]; p1[i] = p; }
                st8_fp8(U + o, r); }
        }
        if (tl0 + TBK == L) { bf16_t* hp = halo + ((size_t)((seg & 1) * 16 + b) * 2) * 1024 + ch; st8(hp, p2); st8(hp + 1024, p1); }
    }
}

__device__ __forceinline__ void phase_qkvconv(const Args& a, int seg) {
    const int wave = wave_id(), lane = threadIdx.x & 63;
    unsigned char* ws = a.ws;
    bf16_t* halo = (bf16_t*)(ws + WS_HALOQ);
    const int gw = blockIdx.x * 8 + wave, NGW = gridDim.x * 8;
    constexpr int NTB = L / TBK, NU = NB * NTB * 6;
    for (int un = gw; un < NU; un += NGW) {
        const int sl = un % 6, tb = (un / 6) % NTB, b = (un / 6) / NTB, arr = sl >> 1, ch = (sl & 1) * 512 + lane * 8, tl0 = tb * TBK;
        const bf16_t* src = (const bf16_t*)(ws + WS_SLOTS + (size_t)arr * SLOT); bf16_t* dst = arr == 0 ? (bf16_t*)(ws + WS_QC) : (bf16_t*)(ws + WS_SLOTS + (size_t)(4 + arr) * SLOT);
        const float* cw = a.in[I_CONVW] + arr * 1024 + ch;
        float w0[8], w1[8], w2[8], w3[8]; ldf8(cw, w0); ldf8(cw + 3072, w1); ldf8(cw + 2 * 3072, w2); ldf8(cw + 3 * 3072, w3);
        float h3[8], h2[8], h1[8];
        if (tl0 > 0) { const size_t o3 = (size_t)(b * L + tl0 - 3) * D + ch; ld8(src + o3, h3); ld8(src + o3 + D, h2); ld8(src + o3 + 2 * D, h1); }
        else if (seg > 0) { const bf16_t* hp = halo + ((size_t)(((seg - 1) & 1) * 16 + b) * 3) * 3072 + arr * 1024 + ch; ld8(hp, h3); ld8(hp + 3072, h2); ld8(hp + 2 * 3072, h1); }
        else {
#pragma unroll
            for (int i = 0; i < 8; ++i) { h3[i] = 0.f; h2[i] = 0.f; h1[i] = 0.f; } }
#pragma unroll 1
        for (int t0 = 0; t0 < TBK; t0 += 8) {
            u32x4 cwv[8];
#pragma unroll
            for (int q = 0; q < 8; ++q) cwv[q] = *(const u32x4*)(src + (size_t)(b * L + tl0 + t0 + q) * D + ch);
#pragma unroll
            for (int q = 0; q < 8; ++q) { const size_t o = (size_t)(b * L + tl0 + t0 + q) * D + ch; float c[8], r[8]; up8(cwv[q], c);
                float ss = 0.f;
#pragma unroll
                for (int i = 0; i < 8; ++i) { const float y = w0[i] * h3[i] + w1[i] * h2[i] + w2[i] * h1[i] + w3[i] * c[i]; const float sv = y * sigmoidf_(y); r[i] = sv; ss += sv * sv; h3[i] = h2[i]; h2[i] = h1[i]; h1[i] = c[i]; }
                if (arr < 2) {
                    ss += __shfl_xor(ss, 1); ss += __shfl_xor(ss, 2); ss += __shfl_xor(ss, 4); ss += __shfl_xor(ss, 8);
                    float sc = 1.0f / sqrtf(ss + EPS); if (arr == 0) sc *= 0.08838834764831845f;
#pragma unroll
                    for (int i = 0; i < 8; ++i) r[i] *= sc;
                }
                st8(dst + o, r); }
        }
        if (tl0 + TBK == L) { bf16_t* hp = halo + ((size_t)((seg & 1) * 16 + b) * 3) * 3072 + arr * 1024 + ch; st8(hp, h3); st8(hp + 3072, h2); st8(hp + 2 * 3072, h1); }
    }
}

typedef short s16x4 __attribute__((ext_vector_type(4)));
constexpr int HREC = 5888, HR_T2 = 4096, HR_HP = 5120, HR_HT = 5632;
constexpr int NCH = MS / 16;
static_assert((size_t)NCH * NH * HREC <= 3 * SLOT, "hand-over records overlay the dead raw q|k|v slots");
__device__ __forceinline__ bf16x8 tr_frag8(const LAS unsigned char* p0, const LAS unsigned char* p1) {
    const s16x4 a = __builtin_amdgcn_ds_read_tr16_b64_v4i16((LAS s16x4*)p0), b = __builtin_amdgcn_ds_read_tr16_b64_v4i16((LAS s16x4*)p1);
    return __builtin_shufflevector(a, b, 0, 1, 2, 3, 4, 5, 6, 7);
}
__device__ __forceinline__ void phase_gdnprep(const Args& a, LAS unsigned char* lds) {
    const int wave = wave_id(), lane = threadIdx.x & 63, li = lane & 15, quad = lane >> 4, tq = li >> 2, tp = li & 3;
    unsigned char* ws = a.ws;
    const bf16_t* Q = (const bf16_t*)(ws + WS_QC); const bf16_t* Kc = (const bf16_t*)(ws + WS_SLOTS + 5 * SLOT);
    const float* gb = (const float*)(ws + WS_GB); unsigned char* hbase = ws + WS_SLOTS;
    LAS unsigned char* wl = lds + wave * 10240;
    LAS unsigned char* Ki = wl; LAS float* Lt = (LAS float*)(wl + 8192); LAS float* tab = (LAS float*)(wl + 8192 + 1280);
    const int gw = blockIdx.x * 8 + wave, NGW = gridDim.x * 8;
    for (int task = gw; task < NCH * NH; task += NGW) {
        const int ci = task >> 3, h = task & 7, r0 = ci * 16;
        const float gv = gb[(size_t)(r0 + li) * 16 + h], bv = gb[(size_t)(r0 + li) * 16 + 8 + h];
        float G = gv;
#pragma unroll
        for (int o = 1; o < 16; o <<= 1) { const float t = __shfl_up(G, o, 16); if (li >= o) G += t; }
        const float Gl = __shfl(G, 15, 16);
        const size_t rowoff = (size_t)(r0 + li) * D + h * HD + quad * 8;
        bf16x8 kf[4], qf[4];
#pragma unroll
        for (int ks = 0; ks < 4; ++ks) { kf[ks] = *(const bf16x8*)(Kc + rowoff + ks * 32); qf[ks] = *(const bf16x8*)(Q + rowoff + ks * 32); }
#pragma unroll
        for (int ks = 0; ks < 4; ++ks) *(LAS bf16x8*)(Ki + li * 256 + (((4 * ks + quad) ^ li) << 4)) = kf[ks];
        f32x4 accK = {0.f, 0.f, 0.f, 0.f}, accP = {0.f, 0.f, 0.f, 0.f};
#pragma unroll
        for (int ks = 0; ks < 4; ++ks) { accK = __builtin_amdgcn_mfma_f32_16x16x32_bf16(kf[ks], kf[ks], accK, 0, 0, 0); accP = __builtin_amdgcn_mfma_f32_16x16x32_bf16(kf[ks], qf[ks], accP, 0, 0, 0); }
        unsigned char* rec = hbase + (size_t)task * HREC;
        float Gq[4], Bq[4];
#pragma unroll
        for (int r = 0; r < 4; ++r) { Gq[r] = __shfl(G, 4 * quad + r, 16); Bq[r] = __shfl(bv, 4 * quad + r, 16); }
        { float pm[4]; f32x4 lt;
#pragma unroll
          for (int r = 0; r < 4; ++r) { const int j = 4 * quad + r; pm[r] = (li >= j) ? accP[r] * __expf(G - Gq[r]) : 0.f; lt[r] = (j > li) ? Bq[r] * __expf(Gq[r] - G) * accK[r] : 0.f; }
          u32x2 w; w.x = cvt_pk_bf16(pm[0], pm[1]); w.y = cvt_pk_bf16(pm[2], pm[3]); *(u32x2*)(rec + HR_HP + lane * 8) = w;
          *(LAS f32x4*)(Lt + li * 20 + 4 * quad) = lt; }
        const float eG = __expf(G);
        if (lane < 16) { tab[lane] = bv * eG; tab[16 + lane] = bv; *(float*)(rec + HR_HT + lane * 4) = eG; *(float*)(rec + HR_HT + 64 + lane * 4) = __expf(Gl - G); if (lane == 0) *(float*)(rec + HR_HT + 128) = __expf(Gl); }
        LDS_WAIT();
        float t[16];
#pragma unroll
        for (int j = 15; j >= 0; --j) {
            float sacc = (li == j) ? 1.f : 0.f;
#pragma unroll
            for (int mq = 0; mq < 4; ++mq) { if (4 * mq + 3 > j) { const f32x4 lv = *(const LAS f32x4*)(Lt + j * 20 + 4 * mq);
#pragma unroll
                for (int r = 0; r < 4; ++r) { const int m = 4 * mq + r; if (m > j) sacc -= t[m] * lv[r]; } } }
            t[j] = sacc;
        }
        float s1[16], s2[16];
#pragma unroll
        for (int mq = 0; mq < 4; ++mq) { const f32x4 x1 = *(const LAS f32x4*)(tab + 4 * mq), x2 = *(const LAS f32x4*)(tab + 16 + 4 * mq);
#pragma unroll
            for (int r = 0; r < 4; ++r) { s1[4 * mq + r] = x1[r]; s2[4 * mq + r] = x2[r]; } }
        bf16x8 T1, T2;
        { float a1[8], a2[8];
#pragma unroll
          for (int e = 0; e < 8; ++e) { a1[e] = quad == 0 ? t[e] * s1[e] : (quad == 1 ? t[8 + e] * s1[8 + e] : 0.f); a2[e] = quad == 0 ? t[e] * s2[e] : (quad == 1 ? t[8 + e] * s2[8 + e] : 0.f); }
          u32x4 w1, w2; w1.x = cvt_pk_bf16(a1[0], a1[1]); w1.y = cvt_pk_bf16(a1[2], a1[3]); w1.z = cvt_pk_bf16(a1[4], a1[5]); w1.w = cvt_pk_bf16(a1[6], a1[7]);
          w2.x = cvt_pk_bf16(a2[0], a2[1]); w2.y = cvt_pk_bf16(a2[2], a2[3]); w2.z = cvt_pk_bf16(a2[4], a2[5]); w2.w = cvt_pk_bf16(a2[6], a2[7]);
          T1 = __builtin_bit_cast(bf16x8, w1); T2 = __builtin_bit_cast(bf16x8, w2); }
        const int tr0 = (8 * quad + tq) & 15, tr1 = (8 * quad + 4 + tq) & 15;
#define TRA(img, row, c) ((img) + (row) * 256 + (((2 * (c) + (tp >> 1)) ^ (row)) << 4) + (tp & 1) * 8)
        const f32x4 zero4 = {0.f, 0.f, 0.f, 0.f};
#pragma unroll
        for (int ks = 0; ks < 4; ++ks) {
            const f32x4 w0 = __builtin_amdgcn_mfma_f32_16x16x32_bf16(tr_frag8(TRA(Ki, tr0, 2 * ks), TRA(Ki, tr1, 2 * ks)), T1, zero4, 0, 0, 0);
            const f32x4 w1 = __builtin_amdgcn_mfma_f32_16x16x32_bf16(tr_frag8(TRA(Ki, tr0, 2 * ks + 1), TRA(Ki, tr1, 2 * ks + 1)), T1, zero4, 0, 0, 0);
            u32x4 w; w.x = cvt_pk_bf16(-w0[0], -w0[1]); w.y = cvt_pk_bf16(-w0[2], -w0[3]); w.z = cvt_pk_bf16(-w1[0], -w1[1]); w.w = cvt_pk_bf16(-w1[2], -w1[3]);
            *(u32x4*)(rec + ks * 1024 + lane * 16) = w;
        }
        *(u32x4*)(rec + HR_T2 + lane * 16) = __builtin_bit_cast(u32x4, T2);
        LDS_WAIT();
    }
}

constexpr int GS_K = 6144, GS_Q = GS_K + 4096, GS_V = GS_Q + 4096, GS_SLOT = GS_V + 2048, GS_RING = 8, GS_PD = 7;
static_assert(GS_SLOT * GS_RING <= 131072, "ring below the LDS control words");
__device__ __forceinline__ void phase_gdnseq(const Args& a, int seg, LAS unsigned char* lds) {
    const int wave = wave_id(), lane = threadIdx.x & 63, li = lane & 15, quad = lane >> 4, tq = li >> 2, tp = li & 3;
    unsigned char* ws = a.ws;
    const bf16_t* Q = (const bf16_t*)(ws + WS_QC); const bf16_t* Kc = (const bf16_t*)(ws + WS_SLOTS + 5 * SLOT); const bf16_t* Vc = (const bf16_t*)(ws + WS_SLOTS + 6 * SLOT);
    bf16_t* O = (bf16_t*)(ws + WS_SLOTS + 6 * SLOT); const unsigned char* hbase = ws + WS_SLOTS; float* state = (float*)(ws + WS_STATE);
    constexpr int NST = L / 16;
    for (int un = blockIdx.x; un < NB * NH * 2; un += gridDim.x) {
        const int pr = (un >> 4) * 8 + (un & 7), hf = (un >> 3) & 1, b = pr >> 3, h = pr & 7;
        if (wave >= 4) {
            const int lw = wave - 4;
            auto issue = [&](int c) {
                const int cc = c < NST ? c : NST - 1;
                LAS unsigned char* slot = lds + (c % GS_RING) * GS_SLOT;
                const unsigned char* rec = hbase + ((size_t)(b * NST + cc) * NH + h) * HREC;
                __builtin_amdgcn_global_load_lds((const unsigned*)(rec + lw * 1024 + lane * 16), (LAS unsigned*)(slot + lw * 1024), 16, 0, 0);
                const size_t ro = (size_t)(b * L + cc * 16 + 4 * lw + quad) * D + h * HD + ((li ^ (4 * lw + quad)) & 15) * 8;
                __builtin_amdgcn_global_load_lds((const unsigned*)(Kc + ro), (LAS unsigned*)(slot + GS_K + lw * 1024), 16, 0, 0);
                __builtin_amdgcn_global_load_lds((const unsigned*)(Q + ro), (LAS unsigned*)(slot + GS_Q + lw * 1024), 16, 0, 0);
                if (lw < 2) { const int vrow = 8 * lw + (lane >> 3);
                    __builtin_amdgcn_global_load_lds((const unsigned*)(Vc + (size_t)(b * L + cc * 16 + vrow) * D + h * HD + hf * 64 + (((lane & 7) ^ (vrow & 7)) * 8)), (LAS unsigned*)(slot + GS_V + lw * 1024), 16, 0, 0); }
                else __builtin_amdgcn_global_load_lds((const unsigned*)(rec + 4096 + (lw - 2) * 1024 + lane * 16), (LAS unsigned*)(slot + 4096 + (lw - 2) * 1024), 16, 0, 0);
            };
#pragma unroll 1
            for (int c = 0; c < GS_PD; ++c) issue(c);
            asm volatile("s_waitcnt vmcnt(24)" ::: "memory");
            __builtin_amdgcn_s_barrier();
#pragma unroll 1
            for (int s = 0; s < NST; ++s) {
                issue(s + GS_PD);
                asm volatile("s_waitcnt vmcnt(24)" ::: "memory");
                __builtin_amdgcn_s_barrier();
            }
            asm volatile("s_waitcnt vmcnt(0)" ::: "memory");
        } else {
            const int d = wave;
            float* st = state + ((size_t)(b * NH + h) * 128 + 4 * quad) * 128 + hf * 64 + 16 * d + li;
            f32x4 S[8];
#pragma unroll
            for (int c = 0; c < 8; ++c)
#pragma unroll
                for (int r = 0; r < 4; ++r) S[c][r] = seg > 0 ? st[(16 * c + r) * 128] : 0.f;
            bf16_t* orow = O + (size_t)(b * L + 4 * quad) * D + h * HD + hf * 64 + 16 * d + li;
            __builtin_amdgcn_s_barrier(); asm volatile("" ::: "memory");
#pragma unroll 1
            for (int s = 0; s < NST; ++s) {
                const LAS unsigned char* sb = lds + (s % GS_RING) * GS_SLOT;
                bf16x8 Sb[4];
#pragma unroll
                for (int ks = 0; ks < 4; ++ks) { u32x4 w; w.x = cvt_pk_bf16(S[2 * ks][0], S[2 * ks][1]); w.y = cvt_pk_bf16(S[2 * ks][2], S[2 * ks][3]); w.z = cvt_pk_bf16(S[2 * ks + 1][0], S[2 * ks + 1][1]); w.w = cvt_pk_bf16(S[2 * ks + 1][2], S[2 * ks + 1][3]); Sb[ks] = __builtin_bit_cast(bf16x8, w); }
                const int tr0 = (8 * quad + tq) & 15, tr1 = (8 * quad + 4 + tq) & 15;
#define TRV(row) (sb + GS_V + (row) * 128 + (((2 * d + (tp >> 1)) ^ ((row) & 7)) << 4) + (tp & 1) * 8)
                f32x4 vn = __builtin_amdgcn_mfma_f32_16x16x32_bf16(*(const LAS bf16x8*)(sb + HR_T2 + lane * 16), tr_frag8(TRV(tr0), TRV(tr1)), (f32x4){0.f, 0.f, 0.f, 0.f}, 0, 0, 0);
#pragma unroll
                for (int ks = 0; ks < 4; ++ks) vn = __builtin_amdgcn_mfma_f32_16x16x32_bf16(*(const LAS bf16x8*)(sb + ks * 1024 + lane * 16), Sb[ks], vn, 0, 0, 0);
                f32x4 oa = {0.f, 0.f, 0.f, 0.f};
#pragma unroll
                for (int ks = 0; ks < 4; ++ks) {
                    const u32x2 q0 = *(const LAS u32x2*)(sb + GS_Q + li * 256 + (((4 * ks + (quad >> 1)) ^ li) << 4) + (quad & 1) * 8), q1 = *(const LAS u32x2*)(sb + GS_Q + li * 256 + (((4 * ks + 2 + (quad >> 1)) ^ li) << 4) + (quad & 1) * 8);
                    const u32x4 qw = {q0.x, q0.y, q1.x, q1.y};
                    oa = __builtin_amdgcn_mfma_f32_16x16x32_bf16(__builtin_bit_cast(bf16x8, qw), Sb[ks], oa, 0, 0, 0);
                }
                const LAS float* ht = (const LAS float*)(sb + HR_HT);
                const f32x4 eG4 = *(const LAS f32x4*)(ht + 4 * quad), eD4 = *(const LAS f32x4*)(ht + 16 + 4 * quad); const float eGl = ht[32];
                oa = oa * eG4;
                const u32x2 pw = *(const LAS u32x2*)(sb + HR_HP + lane * 8);
                const u32x4 pa = {pw.x, pw.y, 0u, 0u};
                const u32x4 vb = {cvt_pk_bf16(vn[0], vn[1]), cvt_pk_bf16(vn[2], vn[3]), 0u, 0u};
                oa = __builtin_amdgcn_mfma_f32_16x16x32_bf16(__builtin_bit_cast(bf16x8, pa), __builtin_bit_cast(bf16x8, vb), oa, 0, 0, 0);
#pragma unroll
                for (int r = 0; r < 4; ++r) orow[(size_t)(s * 16 + r) * D] = (bf16_t)(cvt_pk_bf16(oa[r], 0.f) & 0xffffu);
                const f32x4 vs = vn * eD4;
                const u32x4 vsw = {cvt_pk_bf16(vs[0], vs[1]), cvt_pk_bf16(vs[2], vs[3]), 0u, 0u};
                const bf16x8 Vs = __builtin_bit_cast(bf16x8, vsw);
#pragma unroll
                for (int c = 0; c < 8; ++c) {
                    const s16x4 kt = __builtin_amdgcn_ds_read_tr16_b64_v4i16((LAS s16x4*)(sb + GS_K + (4 * quad + tq) * 256 + (((2 * c + (tp >> 1)) ^ (4 * quad + tq)) << 4) + (tp & 1) * 8));
                    const bf16x8 ka = __builtin_shufflevector(kt, kt, 0, 1, 2, 3, 4, 5, 6, 7);
                    S[c] = __builtin_amdgcn_mfma_f32_16x16x32_bf16(ka, Vs, S[c] * eGl, 0, 0, 0);
                }
                asm volatile("s_waitcnt lgkmcnt(0)" ::: "memory"); __builtin_amdgcn_s_barrier(); asm volatile("" ::: "memory");
            }
#pragma unroll
            for (int c = 0; c < 8; ++c)
#pragma unroll
                for (int r = 0; r < 4; ++r) st[(16 * c + r) * 128] = S[c][r];
        }
        __syncthreads();
    }
}

__device__ __forceinline__ void phase_gnorm(const Args& a) {
    const int wave = wave_id(), lane = threadIdx.x & 63;
    unsigned char* ws = a.ws;
    const bf16_t* O = (const bf16_t*)(ws + WS_SLOTS + 6 * SLOT); const bf16_t* Z = (const bf16_t*)(ws + WS_SLOTS + 3 * SLOT); unsigned char* ON = ws + WS_SLOTS + 1 * SLOT;
    const int gw = blockIdx.x * 8 + wave, NGW = gridDim.x * 8;
    float gn[8]; ldf8(a.in[I_GNG] + (lane & 15) * 8, gn);
    for (int it0 = gw; it0 < MS * 2; it0 += 4 * NGW) {
        u32x4 ow[4], zw[4]; size_t off[4];
#pragma unroll
        for (int q = 0; q < 4; ++q) { const int it = it0 + q * NGW; off[q] = (size_t)(it >> 1) * D + (it & 1) * 512 + lane * 8;
            if (it < MS * 2) { ow[q] = *(const u32x4*)(O + off[q]); zw[q] = *(const u32x4*)(Z + off[q]); } }
#pragma unroll
        for (int q = 0; q < 4; ++q) { const int it = it0 + q * NGW; if (it < MS * 2) {
            float ov[8] = {bflo(ow[q].x), bfhi(ow[q].x), bflo(ow[q].y), bfhi(ow[q].y), bflo(ow[q].z), bfhi(ow[q].z), bflo(ow[q].w), bfhi(ow[q].w)};
            float zv[8] = {bflo(zw[q].x), bfhi(zw[q].x), bflo(zw[q].y), bfhi(zw[q].y), bflo(zw[q].z), bfhi(zw[q].z), bflo(zw[q].w), bfhi(zw[q].w)};
            float r[8], ss = 0.f;
#pragma unroll
            for (int i = 0; i < 8; ++i) ss += ov[i] * ov[i];
            ss += __shfl_xor(ss, 1); ss += __shfl_xor(ss, 2); ss += __shfl_xor(ss, 4); ss += __shfl_xor(ss, 8);
            const float rs = 1.0f / sqrtf(ss * (1.0f / HD) + EPS);
#pragma unroll
            for (int i = 0; i < 8; ++i) r[i] = ov[i] * rs * gn[i] * (zv[i] * sigmoidf_(zv[i]));
            st8_fp8(ON + off[q], r); } }
    }
}

__device__ __forceinline__ void phase_router(const Args& a, int seg, LAS unsigned char* lds) {
    const int tid = threadIdx.x, wave = wave_id(), lane = threadIdx.x & 63;
    unsigned char* ws = a.ws;
    const bf16_t* hsrc = (const bf16_t*)a.out; unsigned char* hb = ws + WS_SLOTS + 9 * SLOT; const bf16_t* wrt = (const bf16_t*)(ws + WS_WR);
    float* rs2 = (float*)(ws + WS_RS2); int* tope = (int*)(ws + WS_TOPE); float* topw = (float*)(ws + WS_TOPW); int* hist = (int*)(ws + WS_HIST); int* rowtok = (int*)(ws + WS_ROWTOK);
    LAS int* lhist = (LAS int*)lds; LAS float* lg = (LAS float*)(lds + 1024) + wave * (16 * 33);
    const int tk = lane & 15, quad = lane >> 4;
    for (int i = blockIdx.x * 512 + tid; i < MAXT * 256; i += gridDim.x * 512) rowtok[i] = 0;
    for (int g = blockIdx.x; g < NG; g += gridDim.x) {
        if (tid < 32) lhist[tid] = 0;
        __syncthreads();
        const int r = g * 128 + wave * 16 + tk; const int Rg = grow(seg, r);
        const bf16_t* hr = hsrc + (size_t)Rg * (2 * D) + quad * 8; unsigned char* ho = hb + (size_t)r * D + quad * 8;
        const bf16_t* w0 = wrt + (size_t)tk * D + quad * 8; const bf16_t* w1 = w0 + 16 * D;
        f32x4 acc0 = {0.f, 0.f, 0.f, 0.f}, acc1 = {0.f, 0.f, 0.f, 0.f}; float ss = 0.f;
        u32x4 keep[32];
#pragma unroll
        for (int ks = 0; ks < 32; ++ks) {
            const u32x4 k = *(const u32x4*)(hr + ks * 32); keep[ks] = k;
            const float e0 = bflo(k.x), e1 = bfhi(k.x), e2 = bflo(k.y), e3 = bfhi(k.y), e4 = bflo(k.z), e5 = bfhi(k.z), e6 = bflo(k.w), e7 = bfhi(k.w);
            ss += (e0 * e0 + e1 * e1) + (e2 * e2 + e3 * e3) + (e4 * e4 + e5 * e5) + (e6 * e6 + e7 * e7);
        }
        ss += __shfl_xor(ss, 16); ss += __shfl_xor(ss, 32);
        const float rs = 1.0f / sqrtf(ss * (1.0f / D) + EPS);
        asm volatile("" ::: "memory");
#pragma unroll
        for (int ks = 0; ks < 32; ++ks) {
            u32x4 k = keep[ks]; asm volatile("" : "+v"(k));
            const float e0 = bflo(k.x) * rs, e1 = bfhi(k.x) * rs, e2 = bflo(k.y) * rs, e3 = bfhi(k.y) * rs, e4 = bflo(k.z) * rs, e5 = bfhi(k.z) * rs, e6 = bflo(k.w) * rs, e7 = bfhi(k.w) * rs;
            u32x4 p; p.x = cvt_pk_bf16(e0, e1); p.y = cvt_pk_bf16(e2, e3); p.z = cvt_pk_bf16(e4, e5); p.w = cvt_pk_bf16(e6, e7);
            { u32x2 p8; p8.x = cvt_pk4_fp8(e0, e1, e2, e3); p8.y = cvt_pk4_fp8(e4, e5, e6, e7); *(u32x2*)(ho + ks * 32) = p8; }
            const bf16x8 f0 = *(const bf16x8*)(w0 + ks * 32), f1 = *(const bf16x8*)(w1 + ks * 32);
            acc0 = __builtin_amdgcn_mfma_f32_16x16x32_bf16(f0, __builtin_bit_cast(bf16x8, p), acc0, 0, 0, 0);
            acc1 = __builtin_amdgcn_mfma_f32_16x16x32_bf16(f1, __builtin_bit_cast(bf16x8, p), acc1, 0, 0, 0);
            if ((ks & 3) == 3) asm volatile("" ::: "memory");
        }
#pragma unroll
        for (int j = 0; j < 4; ++j) { lg[tk * 33 + quad * 4 + j] = acc0[j] + a.in[I_BR][quad * 4 + j]; lg[tk * 33 + 16 + quad * 4 + j] = acc1[j] + a.in[I_BR][16 + quad * 4 + j]; }
        LDS_WAIT();
        if (lane < 16) {
            float v0 = -3.0e38f, v1 = -3.0e38f, v2 = -3.0e38f, v3 = -3.0e38f; int i0 = 0, i1 = 0, i2 = 0, i3 = 0;
            for (int e = 0; e < NE; ++e) { const float xv = lg[lane * 33 + e];
                if (xv > v3) { if (xv > v2) { v3 = v2; i3 = i2; if (xv > v1) { v2 = v1; i2 = i1; if (xv > v0) { v1 = v0; i1 = i0; v0 = xv; i0 = e; } else { v1 = xv; i1 = e; } } else { v2 = xv; i2 = e; } } else { v3 = xv; i3 = e; } } }
            const float e1 = expf(v1 - v0), e2 = expf(v2 - v0), e3 = expf(v3 - v0), inv = 1.0f / (1.0f + e1 + e2 + e3);
            *(i32x4*)(tope + (size_t)r * 4) = (i32x4){i0, i1, i2, i3}; *(f32x4*)(topw + (size_t)r * 4) = (f32x4){inv, e1 * inv, e2 * inv, e3 * inv};
            rs2[r] = rs;
            atomicAdd((int*)&lhist[i0], 1); atomicAdd((int*)&lhist[i1], 1); atomicAdd((int*)&lhist[i2], 1); atomicAdd((int*)&lhist[i3], 1);
        }
        __syncthreads();
        if (tid < 32) hist[g * 32 + tid] = lhist[tid];
        __syncthreads();
    }
}

__device__ __forceinline__ void phase_positions(const Args& a, LAS unsigned char* lds) {
    const int tid = threadIdx.x, wave = wave_id(), lane = threadIdx.x & 63;
    unsigned char* ws = a.ws;
    const int* hist = (const int*)(ws + WS_HIST); const int* tope = (const int*)(ws + WS_TOPE); int* dest = (int*)(ws + WS_DEST); int* rowtok = (int*)(ws + WS_ROWTOK); int* meta = (int*)(ws + WS_META);
    LAS int* tot = (LAS int*)lds; LAS int* pre = tot + 32; LAS int* pstart = pre + 32; LAS int* wcnt = pstart + 32;
    for (int g = blockIdx.x; g < NG; g += gridDim.x) {
        if (tid < 64) tot[tid] = 0;
        __syncthreads();
        { const int e = tid & 31, part = tid >> 5; int t_ = 0, p_ = 0;
          for (int gg = part; gg < NG; gg += 16) { const int hv = hist[gg * 32 + e]; t_ += hv; if (gg < g) p_ += hv; }
          atomicAdd((int*)&tot[e], t_); atomicAdd((int*)&pre[e], p_); }
        __syncthreads();
        if (tid == 0) { int run = 0; for (int e = 0; e < NE; ++e) { pstart[e] = run; run += ((tot[e] + 255) >> 8) << 8; } if (g == 0) meta[0] = run >> 8; }
        __syncthreads();
        if (g == 0 && tid < 32) { const int t0 = pstart[tid] >> 8, t1 = t0 + ((tot[tid] + 255) >> 8); for (int t = t0; t < t1; ++t) meta[64 + t] = tid; }
        const int tokr = g * 128 + (tid >> 2), kx = tid & 3; const int my_e = tope[(size_t)tokr * 4 + kx];
        int rk = 0;
#pragma nounroll
        for (int e = 0; e < NE; ++e) { const unsigned long long mask = __ballot(my_e == e); if (my_e == e) rk = __popcll(mask & ((1ull << lane) - 1ull)); if (lane == 0) wcnt[wave * 32 + e] = __popcll(mask); }
        __syncthreads();
        int off = 0;
        for (int w = 0; w < wave; ++w) off += wcnt[w * 32 + my_e];
        const int dst = pstart[my_e] + pre[my_e] + off + rk;
        dest[(size_t)tokr * 4 + kx] = dst; rowtok[dst] = tokr;
        __syncthreads();
    }
}

__device__ __forceinline__ void phase_combine(const Args& a, int seg) {
    const int wave = wave_id(), lane = threadIdx.x & 63;
    unsigned char* ws = a.ws;
    const unsigned char* Y = ws + WS_Y; const int* dest = (const int*)(ws + WS_DEST); const float* topw = (const float*)(ws + WS_TOPW);
    const int gw = blockIdx.x * 8 + wave, NGW = gridDim.x * 8;
    f32x4 gf[4];
#pragma unroll
    for (int j = 0; j < 4; ++j) gf[j] = *(const f32x4*)(a.in[I_NFIN] + lane * 4 + 256 * j);
    for (int r = gw; r < MS; r += NGW) {
        float* hp = a.out + (size_t)grow(seg, r) * D + lane * 4; const bf16_t* hb16 = (const bf16_t*)(a.out + (size_t)grow(seg, r) * D) + lane * 4;
        const i32x4 dd = *(const i32x4*)(dest + (size_t)r * 4); const f32x4 ww = *(const f32x4*)(topw + (size_t)r * 4);
        f32x4 v[4];
#pragma unroll
        for (int j = 0; j < 4; ++j) { const u32x2 hw = *(const u32x2*)(hb16 + 256 * j); v[j] = (f32x4){bflo(hw.x), bfhi(hw.x), bflo(hw.y), bfhi(hw.y)}; }
#pragma unroll
        for (int k = 0; k < 4; ++k) { const unsigned char* yr = Y + (size_t)dd[k] * D + lane * 4; const float wk = ww[k];
#pragma unroll
            for (int j = 0; j < 4; ++j) { const unsigned p = *(const unsigned*)(yr + 256 * j);
                const f32x2 lo = __builtin_amdgcn_cvt_pk_f32_fp8((int)p, false), hi = __builtin_amdgcn_cvt_pk_f32_fp8((int)p, true);
                v[j][0] += wk * lo.x; v[j][1] += wk * lo.y; v[j][2] += wk * hi.x; v[j][3] += wk * hi.y; } }
        float ss = 0.f;
#pragma unroll
        for (int j = 0; j < 4; ++j) ss += (v[j][0] * v[j][0] + v[j][1] * v[j][1]) + (v[j][2] * v[j][2] + v[j][3] * v[j][3]);
#pragma unroll
        for (int o = 1; o < 64; o <<= 1) ss += __shfl_xor(ss, o);
        const float rs = 1.0f / sqrtf(ss * (1.0f / D) + EPS);
#pragma unroll
        for (int j = 0; j < 4; ++j) *(f32x4*)(hp + 256 * j) = v[j] * rs * gf[j];
    }
}

constexpr int NPH = 14;
__device__ __forceinline__ bool in_range(int k) { const Args a = load_args(); return a.ph_lo <= k && k < a.ph_hi; }
__device__ __forceinline__ bool seg_on(int sgi) { const Args a = load_args(); return a.seg_lo <= sgi && sgi < a.seg_hi; }
__device__ __forceinline__ bool do_pro() { const Args a = load_args(); return a.do_pro != 0; }
__global__ void __launch_bounds__(512, 2) hyb_fwd(Args args_unused) {
    extern __shared__ __attribute__((aligned(16))) unsigned char lds_raw[];
    LAS unsigned char* lds = (LAS unsigned char*)lds_raw;
    const int tid = threadIdx.x;
    volatile LAS unsigned* MISC = (volatile LAS unsigned*)(lds + MISC_OFF);
    if (tid < 32) MISC[tid] = 0u;
    __syncthreads();
    if (!MK_MULTI) { const Args a0 = load_args(); (void)xcd_barrier_post((unsigned*)(a0.ws + WS_CTL) + CW_BAR, MISC + 8); }
#define GRID_BAR() do { if (!MK_MULTI) { XcdBarrier b_; { const Args ab_ = load_args(); b_.bar = (unsigned*)(ab_.ws + WS_CTL) + CW_BAR; } b_.x = xb_xcc_id(); b_.st = (volatile LAS unsigned*)(lds + MISC_OFF) + 8; xcd_barrier(b_); } } while (0)
#define IN(k) ((ONLY < 0 || ONLY == (k)) && in_range(k))
#define SEG_ON(s) seg_on(s)
#define DO_PRO do_pro()
    if ((ONLY < 0 || ONLY == 99) && DO_PRO) REPS(20) { const Args args = load_args(); phase_prep(args, lds); GRID_BAR(); }

#define SEG_BODY(SEGC) if (SEG_ON(SEGC)) { constexpr int seg = (SEGC); \
        if (IN(0)) REPS(0) { const Args args = load_args(); unsigned char* ws = args.ws; (void)ws; phase_cast(args, seg); GRID_BAR(); } \
        if (IN(1)) REPS(1) { const Args args = load_args(); unsigned char* ws = args.ws; (void)ws; \
            pg8::SchedDense S; S.init(MS / 256, NIN / 256, gridDim.x, blockIdx.x, 4); S.A = (const char*)(ws + WS_SLOTS + 9 * SLOT); S.B = (const char*)(ws + WS_WIN); \
            pg8::EpiInProj E{(bf16_t*)(ws + WS_SLOTS), (const float*)(ws + WS_RS1), args.out, seg}; \
            pg8::gemm_phase<pg8::EpiInProj, pg8::SchedDense, PG8_ALIGN, PG8_SP2>(lds, S, E); \
            GRID_BAR(); \
        } \
        if (IN(2)) REPS(2) { const Args args = load_args(); unsigned char* ws = args.ws; (void)ws; phase_sconv(args, seg); }   \
        if (IN(3)) REPS(3) { const Args args = load_args(); unsigned char* ws = args.ws; (void)ws; phase_qkvconv(args, seg); GRID_BAR(); } \
        if (IN(4)) REPS(4) { const Args args = load_args(); unsigned char* ws = args.ws; (void)ws; phase_gdnprep(args, lds); GRID_BAR(); } \
        if (IN(5)) REPS(5) { const Args args = load_args(); unsigned char* ws = args.ws; (void)ws; phase_gdnseq(args, seg, lds); GRID_BAR(); } \
        if (IN(6)) REPS(6) { const Args args = load_args(); unsigned char* ws = args.ws; (void)ws; phase_gnorm(args); GRID_BAR(); } \
        if (IN(7)) REPS(7) { const Args args = load_args(); unsigned char* ws = args.ws; (void)ws; \
            { pg8::SchedMerge S; S.init(MS / 256, 4, gridDim.x, blockIdx.x); S.A0 = (const char*)(ws + WS_SLOTS + 1 * SLOT); S.B0 = (const char*)(ws + WS_WOG); S.A1 = (const char*)(ws + WS_SLOTS + 10 * SLOT); S.B1 = (const char*)(ws + WS_WOS); \
              pg8::EpiMerge E{(bf16_t*)(ws + WS_SLOTS + 2 * SLOT), (const bf16_t*)(ws + WS_SLOTS + 7 * SLOT), (const bf16_t*)(ws + WS_SLOTS + 8 * SLOT)}; \
              pg8::gemm_phase<pg8::EpiMerge, pg8::SchedMerge, PG8_ALIGN, PG8_SP2>(lds, S, E); } \
            GRID_BAR(); \
        } \
        if (IN(8)) REPS(8) { const Args args = load_args(); unsigned char* ws = args.ws; (void)ws; \
            pg8::SchedDense S; S.init(MS / 256, 4, gridDim.x, blockIdx.x); S.A = (const char*)(ws + WS_SLOTS + 2 * SLOT); S.B = (const char*)(ws + WS_WMX); \
            pg8::EpiMix E{(const bf16_t*)(ws + WS_SLOTS + 9 * SLOT), (const float*)(ws + WS_RS1), args.out, seg}; \
            pg8::gemm_phase<pg8::EpiMix, pg8::SchedDense, PG8_ALIGN, PG8_SP2>(lds, S, E); \
            GRID_BAR(); \
        } \
        if (IN(9)) REPS(9) { const Args args = load_args(); unsigned char* ws = args.ws; (void)ws; phase_router(args, seg, lds); GRID_BAR(); } \
        if (IN(10)) REPS(10) { const Args args = load_args(); unsigned char* ws = args.ws; (void)ws; phase_positions(args, lds); GRID_BAR(); } \
        if (IN(11)) REPS(11) { const Args args = load_args(); unsigned char* ws = args.ws; (void)ws; \
            const int* meta = (const int*)(ws + WS_META); const int ntl = meta[0]; LAS int* tl = (LAS int*)(lds + TILE_E_OFF); \
            for (int i = threadIdx.x; i < ntl; i += 512) tl[i] = meta[64 + i]; \
            __syncthreads(); \
            pg8::SchedMoe1 S; S.init(ntl, 8, gridDim.x, blockIdx.x, 4); S.A = (const char*)(ws + WS_SLOTS + 9 * SLOT); S.B = (const char*)(ws + WS_WGU); S.rowtok = (const int*)(ws + WS_ROWTOK); S.tile_e = tl; \
            pg8::EpiMoe1 E{ws + WS_HID, tl, (const bf16_t*)(ws + WS_BGU16)}; \
            pg8::gemm_phase<pg8::EpiMoe1, pg8::SchedMoe1, PG8_ALIGN, PG8_SP2>(lds, S, E); \
            GRID_BAR(); \
        } \
        if (IN(12)) REPS(12) { const Args args = load_args(); unsigned char* ws = args.ws; (void)ws; \
            const int* meta = (const int*)(ws + WS_META); const int ntl = meta[0]; LAS int* tl = (LAS int*)(lds + TILE_E_OFF); \
            for (int i = threadIdx.x; i < ntl; i += 512) tl[i] = meta[64 + i]; \
            __syncthreads(); \
            pg8::SchedMoe2 S; S.init(ntl, 4, gridDim.x, blockIdx.x, 4); S.A = (const char*)(ws + WS_HID); S.B = (const char*)(ws + WS_WDN); S.tile_e = tl; \
            pg8::EpiMoe2 E{ws + WS_Y, tl, (const bf16_t*)(ws + WS_BDN16)}; \
            pg8::gemm_phase<pg8::EpiMoe2, pg8::SchedMoe2, PG8_ALIGN, PG8_SP2>(lds, S, E); \
            GRID_BAR(); \
        } \
        if (IN(13)) REPS(13) { const Args args = load_args(); unsigned char* ws = args.ws; (void)ws; phase_combine(args, seg); } \
    }
    SEG_BODY(0)
    SEG_BODY(1)
    static_assert(NSEG == 2, "one SEG_BODY per segment");
#undef SEG_BODY
#undef IN
#undef GRID_BAR
}

extern "C" void kernel_launch(void* const* d_in, const int* in_sizes, int n_in, void* d_out, int out_size, void* d_ws, size_t ws_size, hipStream_t stream) {
    static int grid = 0;
    if (grid == 0) {
        if (n_in != 19 || out_size != NB * SEQ * D || ws_size < WS_END) { fprintf(stderr, "kernel_launch: unexpected shapes / workspace (%d inputs, out %d, ws %zu < %zu)\n", n_in, out_size, ws_size, (size_t)WS_END); grid = -1; return; }
        int dev = 0, cus = 0;
        if (hipGetDevice(&dev) != hipSuccess || hipDeviceGetAttribute(&cus, hipDeviceAttributeMultiprocessorCount, dev) != hipSuccess) { grid = -1; return; }
        if (hipFuncSetAttribute((const void*)hyb_fwd, hipFuncAttributeMaxDynamicSharedMemorySize, LDS_BYTES) != hipSuccess) { fprintf(stderr, "kernel_launch: hipFuncSetAttribute failed\n"); grid = -1; return; }
        int per_cu = 0;
        if (hipOccupancyMaxActiveBlocksPerMultiprocessor(&per_cu, (const void*)hyb_fwd, 512, LDS_BYTES) != hipSuccess || per_cu < 1) fprintf(stderr, "kernel_launch: occupancy query reports %d\n", per_cu);
        (void)hipGetLastError();
        grid = cus;
    }
    if (grid < 0) return;
    (void)in_sizes;
    hipMemsetAsync((char*)d_ws + WS_CTL, 0, CTL_BYTES, stream);
    Args a{};
    for (int i = 0; i < 19; ++i) a.in[i] = (const float*)d_in[i];
    a.out = (float*)d_out; a.ws = (unsigned char*)d_ws;
#if MK_MULTI
    a.do_pro = 1; a.seg_lo = 0; a.seg_hi = 0; a.ph_lo = 0; a.ph_hi = 0;
    hipLaunchKernelGGL(hyb_fwd, dim3(grid), dim3(512), LDS_BYTES, stream, a);
    for (int s = 0; s < NSEG; ++s)
        for (int p = 0; p < NPH; ++p) { a.do_pro = 0; a.seg_lo = s; a.seg_hi = s + 1; a.ph_lo = p; a.ph_hi = p + 1; hipLaunchKernelGGL(hyb_fwd, dim3(grid), dim3(512), LDS_BYTES, stream, a); }
#else
    a.do_pro = 1; a.seg_lo = 0; a.seg_hi = NSEG; a.ph_lo = 0; a.ph_hi = NPH;
    hipLaunchKernelGGL(hyb_fwd, dim3(grid), dim3(512), LDS_BYTES, stream, a);
#endif
}
```

```cpp
#include <hip/hip_runtime.h>
#include <cstdio>
#include <cstdint>

#ifndef ONLY
#define ONLY -1
#endif
#ifndef PROBE_MASK
#define PROBE_MASK 0
#endif
#define REPS(k) for (int rep_ = 0; rep_ < (((PROBE_MASK >> (k)) & 1) ? 2 : 1); ++rep_)
#ifndef MK_MULTI
#define MK_MULTI 0
#endif

#define LAS __attribute__((address_space(3)))
typedef unsigned short bf16_t;
typedef short bf16x8 __attribute__((ext_vector_type(8)));
typedef float f32x4 __attribute__((ext_vector_type(4)));
typedef float f32x2 __attribute__((ext_vector_type(2)));
typedef unsigned u32x4 __attribute__((ext_vector_type(4)));
typedef unsigned u32x2 __attribute__((ext_vector_type(2)));
typedef int i32x4 __attribute__((ext_vector_type(4)));

constexpr int D = 1024, NB = 16, SEQ = 4096, NH = 8, HD = 128, NE = 32;
constexpr int NSEG = 2, L = SEQ / NSEG, LLOG = 11, MS = NB * L;
static_assert((1 << LLOG) == L, "LLOG");
constexpr int DIN = 9232, NIN = 9216;
constexpr int MAXT = (4 * MS + NE * 255) / 256;
static_assert(MAXT * 4 <= 147456 - (131072 + 1024), "tile table fits the LDS tail");
constexpr int NG = MS / 128;
constexpr float EPS = 1e-6f;

constexpr size_t MiB = (size_t)1 << 20;
constexpr size_t WS_CTL = 0, CTL_BYTES = 1 * MiB;
constexpr size_t WS_WIN = 1 * MiB;
constexpr size_t WS_WAB = 19 * MiB;
constexpr size_t WS_WR = 19 * MiB + 65536;
constexpr size_t WS_BGU16 = 19 * MiB + 131072;
constexpr size_t WS_BDN16 = 19 * MiB + 131072 + 131072;
constexpr size_t WS_WOG = 20 * MiB, WS_WOS = 22 * MiB, WS_WMX = 24 * MiB;
constexpr size_t WS_WGU = 26 * MiB;
constexpr size_t WS_WDN = 154 * MiB;
constexpr size_t WS_STATE = 218 * MiB;
constexpr size_t WS_MISC = 226 * MiB;
constexpr size_t WS_RS1 = WS_MISC;
constexpr size_t WS_RS2 = WS_RS1 + (size_t)MS * 4;
constexpr size_t WS_GB = WS_RS2 + (size_t)MS * 4;
constexpr size_t WS_TOPE = WS_GB + (size_t)MS * 64;
constexpr size_t WS_TOPW = WS_TOPE + (size_t)MS * 16;
constexpr size_t WS_DEST = WS_TOPW + (size_t)MS * 16;
constexpr size_t WS_HIST = WS_DEST + (size_t)MS * 16;
constexpr size_t WS_ROWTOK = WS_HIST + (size_t)NG * 128;
constexpr size_t WS_HALOQ = WS_ROWTOK + (size_t)MAXT * 1024;
constexpr size_t WS_HALOS = WS_HALOQ + (size_t)2 * 16 * 3 * 3072 * 2;
constexpr size_t WS_META = WS_HALOS + (size_t)2 * 16 * 2 * 1024 * 2;
constexpr size_t WS_MISC_END = WS_META + 4096 + (size_t)MAXT * 4;
constexpr size_t WS_SLOTS = 234 * MiB;
static_assert(WS_MISC_END <= WS_SLOTS, "misc region");
constexpr size_t SLOT = (size_t)MS * D * 2;
constexpr int NSLOT = 11;
constexpr size_t WS_QC = WS_SLOTS + NSLOT * SLOT;
constexpr size_t WS_END = WS_QC + SLOT;
constexpr size_t HID_BYTES = (size_t)MAXT * 256 * 2048;
constexpr size_t WS_HID = WS_SLOTS, WS_Y = WS_SLOTS + ((HID_BYTES + MiB - 1) / MiB) * MiB;
static_assert(WS_Y + HID_BYTES <= WS_SLOTS + 9 * SLOT, "MoE buffers overlay the dead projection slots");
constexpr int CW_BAR = 4096;

constexpr int LDS_BYTES = 147456, MISC_OFF = 131072 + 320, TILE_E_OFF = 131072 + 1024;

typedef __bf16 bf16v2_t __attribute__((ext_vector_type(2)));
__device__ __forceinline__ unsigned cvt_pk_bf16(float lo, float hi) { const f32x2 v = {lo, hi}; return __builtin_bit_cast(unsigned, __builtin_convertvector(v, bf16v2_t)); }
__device__ __forceinline__ float bflo(unsigned w) { return __uint_as_float(w << 16); }
__device__ __forceinline__ float bfhi(unsigned w) { return __uint_as_float(w & 0xffff0000u); }
__device__ __forceinline__ float sigmoidf_(float x) { return __builtin_amdgcn_rcpf(1.0f + __expf(-x)); }
__device__ __forceinline__ int grow(int seg, int r) { return ((r >> LLOG) << 12) + seg * L + (r & (L - 1)); }
__device__ __forceinline__ float sat8(float v) { return __builtin_amdgcn_fmed3f(v, -448.0f, 448.0f); }
__device__ __forceinline__ unsigned cvt_pk4_fp8(float a, float b, float c, float d) { int w = __builtin_amdgcn_cvt_pk_fp8_f32(a, b, 0, false); w = __builtin_amdgcn_cvt_pk_fp8_f32(c, d, w, true); return (unsigned)w; }
#define LDS_WAIT() asm volatile("s_waitcnt lgkmcnt(0)" ::: "memory")
__device__ __forceinline__ int wave_id() { int t = (int)threadIdx.x; asm volatile("" : "+v"(t)); return __builtin_amdgcn_readfirstlane(t >> 6); }

#define XB_TMO      128
#define XB_XCNT(j)  (256  + 64 * (j))
#define XB_XSUB(j)  (1280 + 64 * (j))
#define XB_XGEN(j)  (2304 + 64 * (j))
#define XB_TOP      3328
#define XB_TOPGEN   3392
#define XCD_BAR_WORDS 3456
#define XB_SPIN_CAP (1u << 20)
__device__ __forceinline__ unsigned xb_ld(unsigned* p)              { return __hip_atomic_load(p, __ATOMIC_RELAXED, __HIP_MEMORY_SCOPE_AGENT); }
__device__ __forceinline__ unsigned xb_add(unsigned* p, unsigned v) { return __hip_atomic_fetch_add(p, v, __ATOMIC_RELAXED, __HIP_MEMORY_SCOPE_AGENT); }
__device__ __forceinline__ unsigned xb_xcc_id() { return (unsigned)__builtin_amdgcn_s_getreg((3 << 11) | 20) & 0xFu; }
#define XB_SPIN(cond, bar) do { unsigned _sp = 0; while (cond) { __builtin_amdgcn_s_sleep(1); \
    if ((++_sp & 255u) == 0u) { if (xb_ld(&(bar)[XB_TMO])) break; if (_sp > XB_SPIN_CAP) { atomicAdd(&(bar)[XB_TMO], 1u); break; } } } } while (0)
struct XcdBarrier { unsigned* bar; unsigned x; volatile LAS unsigned* st; };
__device__ __forceinline__ XcdBarrier xcd_barrier_post(unsigned* bar, volatile LAS unsigned* st) {
    XcdBarrier b; b.bar = bar; b.x = xb_xcc_id(); b.st = st;
    if (threadIdx.x == 0) (void)xb_add(&bar[XB_XCNT(b.x)], 1u);
    return b;
}
__device__ __forceinline__ void xcd_barrier_complete(unsigned* bar, unsigned x, unsigned& nloc, unsigned& nx) {
    const unsigned G = gridDim.x * gridDim.y * gridDim.z;
    unsigned sum, cnt, mine, sp = 0u;
    for (;;) {
        sum = 0u; cnt = 0u; mine = 0u;
#pragma unroll
        for (unsigned j = 0; j < 16; ++j) { const unsigned c = xb_ld(&bar[XB_XCNT(j)]); sum += c; cnt += (c > 0u) ? 1u : 0u; mine = (j == x) ? c : mine; }
        if (sum == G) break;
        __builtin_amdgcn_s_sleep(1);
        if ((++sp & 255u) == 0u) { if (xb_ld(&bar[XB_TMO])) break; if (sp > XB_SPIN_CAP) { atomicAdd(&bar[XB_TMO], 1u); break; } }
    }
    nloc = mine > 0u ? mine : 1u; nx = cnt > 0u ? cnt : 1u;
}
__device__ __forceinline__ void xcd_barrier(const XcdBarrier& b) {
    asm volatile("s_waitcnt vmcnt(0)" ::: "memory");
    __syncthreads();
    if (threadIdx.x == 0) {
        unsigned* bar = b.bar;
        __builtin_amdgcn_s_waitcnt(0);
        unsigned nloc = b.st[0], nx = b.st[1];
        if (nloc == 0u) { xcd_barrier_complete(bar, b.x, nloc, nx); b.st[0] = nloc; b.st[1] = nx; }
        const unsigned old = xb_add(&bar[XB_XSUB(b.x)], 1u);
        const unsigned gen = old / nloc;
        if (old + 1u == (gen + 1u) * nloc) {
            __builtin_amdgcn_fence(__ATOMIC_RELEASE, "agent");
            asm volatile("s_waitcnt vmcnt(0)" ::: "memory");
            const unsigned og = xb_add(&bar[XB_TOP], 1u);
            const unsigned tg = og / nx;
            if (og + 1u == (tg + 1u) * nx) xb_add(&bar[XB_TOPGEN], 1u);
            else XB_SPIN(xb_ld(&bar[XB_TOPGEN]) == tg, bar);
            __builtin_amdgcn_fence(__ATOMIC_ACQUIRE, "agent");
            xb_add(&bar[XB_XGEN(b.x)], 1u);
            asm volatile("s_waitcnt vmcnt(0)" ::: "memory");
        } else {
            XB_SPIN(xb_ld(&bar[XB_XGEN(b.x)]) == gen, bar);
            __builtin_amdgcn_fence(__ATOMIC_ACQUIRE, "agent");
            asm volatile("s_waitcnt vmcnt(0)" ::: "memory");
        }
    }
    __syncthreads();
}

namespace pg8 {
constexpr int BM = 256, BK = 64, HALF = 128, HTB = HALF * BK * 2, NXCD = 8, WGM = 8, K = 1024;
__device__ __forceinline__ int lds_byte(int r, int c) { const int st = (r >> 4) * 2 + (c >> 5), rr = r & 15, cc = c & 31, ob = rr * 64 + cc * 2; return st * 1024 + (ob ^ (((ob >> 9) & 1) << 5)); }
__device__ __forceinline__ void stage_rc(int b, int& R, int& C) { const int st = b / 1024, sb = b % 1024, swz = sb ^ (((sb >> 9) & 1) << 5); R = (st >> 1) * 16 + swz / 64; C = (st & 1) * 32 + (swz % 64) / 2; }
__device__ __forceinline__ int perm32(int rho) { const int n = rho >> 4, i = rho & 15; return 8 * (i >> 2) + 4 * n + (i & 3); }
struct Unit { int pm, pn, part; };
typedef int i32x8 __attribute__((ext_vector_type(8)));
typedef int i32x4v __attribute__((ext_vector_type(4)));
__device__ __forceinline__ i32x8 cat8(bf16x8 a, bf16x8 b) { return __builtin_shufflevector(__builtin_bit_cast(i32x4v, a), __builtin_bit_cast(i32x4v, b), 0, 1, 2, 3, 4, 5, 6, 7); }
struct Order {
    int nM, nN, nwg, G, c, wgm;
    __device__ __forceinline__ void init(int nM_, int nN_, int G_, int c_, int wgm_ = 8) { nM = nM_; nN = nN_; nwg = nM * nN; G = G_; c = c_; wgm = wgm_; }
    __device__ __forceinline__ bool next(int i, Unit& u) const {
        const long Lx = (long)i * G + c; if (Lx >= nwg) return false;
        int wgid = (int)Lx; { const int q = nwg / NXCD, r = nwg % NXCD, xcd = wgid % NXCD, off = wgid / NXCD; wgid = (xcd < r ? xcd * (q + 1) : r * (q + 1) + (xcd - r) * q) + off; }
        const int nig = wgm * nN, gid = wgid / nig, fm = gid * wgm, gsz = (nM - fm) < wgm ? (nM - fm) : wgm;
        u.pm = fm + ((wgid % nig) % gsz); u.pn = (wgid % nig) / gsz; u.part = 0; return true;
    }
};
template <int ROWB_> struct SchedDenseT : Order {
    static constexpr bool GATHER = false; static constexpr int ROWB = ROWB_;
    const char* A; const char* B;
    __device__ __forceinline__ const char* a_tile(const Unit& u) const { return A + (size_t)u.pm * (BM * ROWB); }
    __device__ __forceinline__ const char* b_tile(const Unit& u) const { return B + (size_t)u.pn * (BM * ROWB); }
    __device__ __forceinline__ void a_offs(const Unit&, const int (&R)[2], const int (&C)[2], unsigned (&o)[2][2]) const {
#pragma unroll
        for (int h = 0; h < 2; ++h)
#pragma unroll
            for (int i = 0; i < 2; ++i) o[h][i] = (unsigned)((h * HALF + R[i]) * ROWB + C[i] * 2);
    }
};
typedef SchedDenseT<2048> SchedDense; typedef SchedDenseT<1024> SchedDense8;
struct SchedMoe1 : Order {
    static constexpr bool GATHER = true; static constexpr int ROWB = 1024;
    const char* A; const char* B; const int* rowtok; const LAS int* tile_e;
    __device__ __forceinline__ const char* a_tile(const Unit&) const { return A; }
    __device__ __forceinline__ const char* b_tile(const Unit& u) const { return B + ((size_t)__builtin_amdgcn_readfirstlane(tile_e[u.pm]) * 2048 + (size_t)u.pn * BM) * ROWB; }
    __device__ __forceinline__ void a_offs(const Unit& u, const int (&R)[2], const int (&C)[2], unsigned (&o)[2][2]) const {
#pragma unroll
        for (int h = 0; h < 2; ++h)
#pragma unroll
            for (int i = 0; i < 2; ++i) o[h][i] = (unsigned)(rowtok[u.pm * BM + h * HALF + R[i]] * ROWB + C[i] * 2);
    }
};
struct SchedMoe2 : Order {
    static constexpr bool GATHER = false; static constexpr int ROWB = 1024;
    const char* A; const char* B; const LAS int* tile_e;
    __device__ __forceinline__ const char* a_tile(const Unit& u) const { return A + (size_t)u.pm * (BM * ROWB); }
    __device__ __forceinline__ const char* b_tile(const Unit& u) const { return B + ((size_t)__builtin_amdgcn_readfirstlane(tile_e[u.pm]) * 1024 + (size_t)u.pn * BM) * ROWB; }
    __device__ __forceinline__ void a_offs(const Unit&, const int (&R)[2], const int (&C)[2], unsigned (&o)[2][2]) const {
#pragma unroll
        for (int h = 0; h < 2; ++h)
#pragma unroll
            for (int i = 0; i < 2; ++i) o[h][i] = (unsigned)((h * HALF + R[i]) * ROWB + C[i] * 2);
    }
};

struct BReg { u32x4 b[2]; };
struct TReg { u32x4 x[2][4][2]; float inv[2][4]; };
template <class E, class = void> struct has_tinit { static constexpr bool value = false; };
template <class E> struct has_tinit<E, decltype((void)E::TINIT)> { static constexpr bool value = E::TINIT; };
template <class E, class = void> struct has_binit { static constexpr bool value = false; };
template <class E> struct has_binit<E, decltype((void)E::BINIT)> { static constexpr bool value = E::BINIT; };
template <class E, class = void> struct keeps_acc { static constexpr bool value = false; };
template <class E> struct keeps_acc<E, decltype((void)E::KEEP)> { static constexpr bool value = E::KEEP; };
__device__ __forceinline__ void bias_init(f32x4 (&acc)[2][2][4][2], const BReg& r) {
#pragma unroll
    for (int bj = 0; bj < 2; ++bj) { const u32x4 bw = r.b[bj]; const f32x4 b0 = {bflo(bw.x), bfhi(bw.x), bflo(bw.y), bfhi(bw.y)}, b1 = {bflo(bw.z), bfhi(bw.z), bflo(bw.w), bfhi(bw.w)};
#pragma unroll
        for (int ai = 0; ai < 2; ++ai)
#pragma unroll
            for (int m = 0; m < 4; ++m) { acc[ai][bj][m][0] = b0; acc[ai][bj][m][1] = b1; } }
}
__device__ __forceinline__ void tile_init(f32x4 (&acc)[2][2][4][2], const TReg& t) {
#pragma unroll
    for (int ai = 0; ai < 2; ++ai)
#pragma unroll
        for (int m = 0; m < 4; ++m) { const float iv = __builtin_amdgcn_rcpf(t.inv[ai][m]);
#pragma unroll
            for (int bj = 0; bj < 2; ++bj) { const u32x4 xw = t.x[ai][m][bj];
                acc[ai][bj][m][0] = (f32x4){bflo(xw.x), bfhi(xw.x), bflo(xw.y), bfhi(xw.y)} * iv; acc[ai][bj][m][1] = (f32x4){bflo(xw.z), bfhi(xw.z), bflo(xw.w), bfhi(xw.w)} * iv; } }
}
template <class Epi, class Sched, bool ALIGN_EPI, bool SP2>
__device__ __forceinline__ void gemm_phase(LAS unsigned char* lds, const Sched& S, const Epi& E) {
    const int tid = threadIdx.x, wid = wave_id(), lane = tid & 63, wr = wid >> 2, wc = wid & 3, fr = lane & 15, fq = lane >> 4;
    constexpr int ROWB = Sched::ROWB, nt = ROWB / 128; constexpr bool FP8 = (ROWB == 1024);
    int Rr[2], Cc[2]; unsigned voffB[2];
#pragma unroll
    for (int i = 0; i < 2; ++i) { int R, C; stage_rc(tid * 16 + i * 8192, R, C); Rr[i] = R; Cc[i] = C; const int Rb = Epi::PERM ? ((R & ~31) + perm32(R & 31)) : R; voffB[i] = (unsigned)(Rb * ROWB + C * 2); }
    const size_t kstep = (size_t)(BK * 2);
    const size_t hstep = (size_t)HALF * ROWB;
    const unsigned ldsw = (unsigned)wid * 1024u;
    const int aoff = lds_byte(wr * 64 + fr, fq * 8), boff = lds_byte(wc * 32 + fr, fq * 8);
#define PG8_SA(b, h) (((b) * 2 + (h)) * HTB)
#define PG8_SB(b, h) ((4 + (b) * 2 + (h)) * HTB)
#define PG8_STAGE(bufoff, gbase, voff) do { _Pragma("unroll") for (int _i = 0; _i < 2; ++_i) \
        __builtin_amdgcn_global_load_lds((const unsigned*)((const char*)(gbase) + (voff)[_i]), (LAS unsigned*)(lds + (bufoff) + ldsw + _i * 8192), 16, 0, 0); } while (0)
#define PG8_LDA(dst, b, h) do { _Pragma("unroll") for (int m = 0; m < 4; ++m) { if constexpr (FP8) dst##8[m] = cat8(*(const LAS bf16x8*)(lds + PG8_SA(b, h) + aoff + m * 2048), *(const LAS bf16x8*)(lds + PG8_SA(b, h) + aoff + m * 2048 + 1024)); \
        else { _Pragma("unroll") for (int k = 0; k < 2; ++k) dst[m][k] = *(const LAS bf16x8*)(lds + PG8_SA(b, h) + aoff + m * 2048 + k * 1024); } } } while (0)
#define PG8_LDB(dst, b, h) do { _Pragma("unroll") for (int n = 0; n < 2; ++n) { if constexpr (FP8) dst##8[n] = cat8(*(const LAS bf16x8*)(lds + PG8_SB(b, h) + boff + n * 2048), *(const LAS bf16x8*)(lds + PG8_SB(b, h) + boff + n * 2048 + 1024)); \
        else { _Pragma("unroll") for (int k = 0; k < 2; ++k) dst[n][k] = *(const LAS bf16x8*)(lds + PG8_SB(b, h) + boff + n * 2048 + k * 1024); } } } while (0)
#define PG8_MMA(ai, bj, At, Bt) do { __builtin_amdgcn_s_setprio(1); _Pragma("unroll") for (int m = 0; m < 4; ++m) _Pragma("unroll") for (int n = 0; n < 2; ++n) { \
        if constexpr (FP8) asm volatile("s_nop 1\n\tv_mfma_scale_f32_16x16x128_f8f6f4 %0, %1, %2, %0, %3, %4 op_sel_hi:[0,0,0]" : "+v"(acc[ai][bj][m][n]) : "v"(Bt##8[n]), "v"(At##8[m]), "v"(sclW), "v"(sclX)); \
        else { _Pragma("unroll") for (int k = 0; k < 2; ++k) acc[ai][bj][m][n] = __builtin_amdgcn_mfma_f32_16x16x32_bf16(Bt[n][k], At[m][k], acc[ai][bj][m][n], 0, 0, 0); } } \
        __builtin_amdgcn_s_setprio(0); } while (0)
#define PG8_WAIT_V(n) asm volatile("s_waitcnt vmcnt(" #n ")" ::: "memory")
#define PG8_WAIT_L(n) asm volatile("s_waitcnt lgkmcnt(" #n ")" ::: "memory")
#define PG8_BAR __builtin_amdgcn_s_barrier()
#define PG8_SCHED __builtin_amdgcn_sched_barrier(0)
    Unit cur, nxt; int ui = 0;
    if (!S.next(0, cur)) return;
    f32x4 acc[2][2][4][2];
    constexpr bool BINIT = has_binit<Epi>::value;
    constexpr bool TINIT = has_tinit<Epi>::value;
    if constexpr (BINIT) { BReg br; E.bias_load(cur, wr, wc, fr, fq, br); bias_init(acc, br); }
    else if constexpr (TINIT) { TReg tr; E.tile_load(cur, wr, wc, fr, fq, tr); tile_init(acc, tr); }
    else {
#pragma unroll
    for (int a = 0; a < 2; ++a)
#pragma unroll
        for (int b = 0; b < 2; ++b)
#pragma unroll
            for (int m = 0; m < 4; ++m)
#pragma unroll
                for (int n = 0; n < 2; ++n) acc[a][b][m][n] = (f32x4){0.f, 0.f, 0.f, 0.f};
    }
    int sclW = 0x7A7A7A7A, sclX = 0x7F7F7F7F; asm volatile("" : "+v"(sclW), "+v"(sclX));
    bf16x8 At[4][2], B0[2][2], B1[2][2]; i32x8 At8[4], B08[2], B18[2]; (void)At; (void)B0; (void)B1; (void)At8; (void)B08; (void)B18;
    unsigned oC[2][2], oN[2][2]; typename Epi::Pre pre;
    S.a_offs(cur, Rr, Cc, oC);
    const char* cA = S.a_tile(cur); const char* cB = S.b_tile(cur);
    if constexpr (SP2) {
        PG8_STAGE(PG8_SB(0, 0), cB, voffB); PG8_STAGE(PG8_SB(0, 1), cB + hstep, voffB); PG8_STAGE(PG8_SA(0, 0), cA, oC[0]); PG8_STAGE(PG8_SA(0, 1), cA, oC[1]);
        if (wr == 1) PG8_BAR;
        PG8_WAIT_V(2); PG8_BAR;
        PG8_STAGE(PG8_SB(1, 0), cB + kstep, voffB); PG8_STAGE(PG8_SA(1, 0), cA + kstep, oC[0]); PG8_STAGE(PG8_SB(1, 1), cB + hstep + kstep, voffB);
        PG8_WAIT_V(6); PG8_BAR;
    } else {
        PG8_STAGE(PG8_SB(0, 0), cB, voffB); PG8_STAGE(PG8_SA(0, 0), cA, oC[0]); PG8_STAGE(PG8_SB(0, 1), cB + hstep, voffB); PG8_STAGE(PG8_SA(0, 1), cA, oC[1]);
        if (wr == 1) PG8_BAR;
        PG8_WAIT_V(4); PG8_BAR;
        PG8_STAGE(PG8_SB(1, 0), cB + kstep, voffB); PG8_STAGE(PG8_SA(1, 0), cA + kstep, oC[0]); PG8_STAGE(PG8_SB(1, 1), cB + hstep + kstep, voffB);
        PG8_WAIT_V(6); PG8_BAR;
    }
    for (;;) {
        const bool has_next = S.next(ui + 1, nxt);
        const char* nA = cA; const char* nB = cB;
        if (has_next) { nA = S.a_tile(nxt); nB = S.b_tile(nxt); if constexpr (Sched::GATHER) S.a_offs(nxt, Rr, Cc, oN); }
        else if constexpr (Sched::GATHER) {
#pragma unroll
            for (int h = 0; h < 2; ++h)
#pragma unroll
                for (int i = 0; i < 2; ++i) oN[h][i] = oC[h][i];
        }
#pragma nounroll
        for (int t = 0; t < nt; t += 2) {
            const bool last = (t == nt - 2);
            if (last) E.prefetch(cur, wr, wc, fr, fq, pre);
            const char* a1 = cA + (size_t)(t + 1) * kstep;
            const char* a2 = last ? nA : cA + (size_t)(t + 2) * kstep; const char* b2 = last ? nB : cB + (size_t)(t + 2) * kstep;
            const char* a3 = a2 + kstep; const char* b3 = b2 + kstep;
            unsigned o2[2][2];
#pragma unroll
            for (int h = 0; h < 2; ++h)
#pragma unroll
                for (int i = 0; i < 2; ++i) { if constexpr (Sched::GATHER) o2[h][i] = last ? oN[h][i] : oC[h][i]; else o2[h][i] = oC[h][i]; }
            if constexpr (SP2) {
            PG8_LDB(B0, 0, 0); PG8_LDB(B1, 0, 1); PG8_SCHED; PG8_LDA(At, 0, 0); PG8_STAGE(PG8_SA(1, 1), a1, oC[1]);
            PG8_WAIT_V(8); PG8_WAIT_L(0); PG8_BAR; PG8_MMA(0, 0, At, B0); PG8_MMA(0, 1, At, B1); PG8_BAR; PG8_SCHED;
            PG8_LDA(At, 0, 1); PG8_STAGE(PG8_SB(0, 0), b2, voffB); PG8_STAGE(PG8_SB(0, 1), b2 + hstep, voffB); PG8_STAGE(PG8_SA(0, 0), a2, o2[0]);
            PG8_WAIT_V(8); PG8_WAIT_L(0); PG8_BAR; PG8_MMA(1, 0, At, B0); PG8_MMA(1, 1, At, B1); PG8_BAR; PG8_SCHED;
            PG8_LDB(B0, 1, 0); PG8_LDB(B1, 1, 1); PG8_SCHED; PG8_LDA(At, 1, 0); PG8_STAGE(PG8_SA(0, 1), a2, o2[1]);
            PG8_WAIT_V(8); PG8_WAIT_L(0); PG8_BAR; PG8_MMA(0, 0, At, B0); PG8_MMA(0, 1, At, B1); PG8_BAR; PG8_SCHED;
            PG8_LDA(At, 1, 1); PG8_STAGE(PG8_SB(1, 0), b3, voffB); PG8_STAGE(PG8_SB(1, 1), b3 + hstep, voffB); PG8_STAGE(PG8_SA(1, 0), a3, o2[0]);
            PG8_WAIT_V(8); PG8_WAIT_L(0); PG8_BAR; PG8_MMA(1, 0, At, B0); PG8_MMA(1, 1, At, B1); PG8_BAR; PG8_SCHED;
            } else {
            PG8_LDB(B0, 0, 0); PG8_SCHED; PG8_LDA(At, 0, 0); PG8_STAGE(PG8_SA(1, 1), a1, oC[1]);
            PG8_WAIT_L(8); PG8_BAR; PG8_WAIT_L(0); PG8_MMA(0, 0, At, B0); PG8_BAR; PG8_SCHED;
            PG8_LDB(B1, 0, 1); PG8_STAGE(PG8_SB(0, 0), b2, voffB);
            PG8_BAR; PG8_WAIT_L(0); PG8_MMA(0, 1, At, B1); PG8_BAR;
            PG8_LDA(At, 0, 1); PG8_STAGE(PG8_SA(0, 0), a2, o2[0]);
            PG8_BAR; PG8_WAIT_L(0); PG8_MMA(1, 0, At, B0); PG8_BAR; PG8_SCHED;
            PG8_STAGE(PG8_SB(0, 1), b2 + hstep, voffB);
            PG8_WAIT_V(6); PG8_BAR; PG8_MMA(1, 1, At, B1); PG8_BAR;
            PG8_LDB(B0, 1, 0); PG8_SCHED; PG8_LDA(At, 1, 0); PG8_STAGE(PG8_SA(0, 1), a2, o2[1]);
            PG8_WAIT_L(8); PG8_BAR; PG8_WAIT_L(0); PG8_MMA(0, 0, At, B0); PG8_BAR; PG8_SCHED;
            PG8_LDB(B1, 1, 1); PG8_STAGE(PG8_SB(1, 0), b3, voffB);
            PG8_BAR; PG8_WAIT_L(0); PG8_MMA(0, 1, At, B1); PG8_BAR;
            PG8_LDA(At, 1, 1); PG8_STAGE(PG8_SA(1, 0), a3, o2[0]);
            PG8_BAR; PG8_WAIT_L(0); PG8_MMA(1, 0, At, B0); PG8_BAR; PG8_SCHED;
            PG8_STAGE(PG8_SB(1, 1), b3 + hstep, voffB);
            PG8_WAIT_V(6); PG8_BAR; PG8_MMA(1, 1, At, B1); PG8_BAR;
            }
        }
        if constexpr (ALIGN_EPI) { if (wr == 0) PG8_BAR; }
        BReg br; (void)br;
        if constexpr (BINIT) E.bias_load(has_next ? nxt : cur, wr, wc, fr, fq, br);
        if constexpr (FP8) asm volatile("s_nop 15\n\ts_nop 15" ::: "memory");
        E(acc, cur, wr, wc, fr, fq, pre);
        if (!has_next) break;
        if constexpr (BINIT) bias_init(acc, br);
        else if constexpr (TINIT) { TReg tr; E.tile_load(nxt, wr, wc, fr, fq, tr); tile_init(acc, tr); }
        else if (!(keeps_acc<Epi>::value && cur.part == 0)) {
#pragma unroll
        for (int a = 0; a < 2; ++a)
#pragma unroll
            for (int b = 0; b < 2; ++b)
#pragma unroll
                for (int m = 0; m < 4; ++m)
#pragma unroll
                    for (int n = 0; n < 2; ++n) acc[a][b][m][n] = (f32x4){0.f, 0.f, 0.f, 0.f};
        }
        cur = nxt; cA = nA; cB = nB; ++ui;
        if constexpr (Sched::GATHER) {
#pragma unroll
        for (int h = 0; h < 2; ++h)
#pragma unroll
            for (int i = 0; i < 2; ++i) oC[h][i] = oN[h][i]; }
        if constexpr (ALIGN_EPI) { if (wr == 1) PG8_BAR; }
    }
    PG8_WAIT_V(0);
    if constexpr (!ALIGN_EPI) { if (wr == 0) PG8_BAR; }
    PG8_BAR;
#undef PG8_SA
#undef PG8_SB
#undef PG8_STAGE
#undef PG8_LDA
#undef PG8_LDB
#undef PG8_MMA
#undef PG8_WAIT_V
#undef PG8_WAIT_L
#undef PG8_BAR
#undef PG8_SCHED
}

typedef f32x4 Acc[2][2][4][2];
__device__ __forceinline__ u32x4 widen16(u32x2 xa, u32x2 xb) {
    const auto r0 = __builtin_amdgcn_permlane16_swap(xa.x, xb.x, false, false), r1 = __builtin_amdgcn_permlane16_swap(xa.y, xb.y, false, false);
    return (u32x4){r0[0], r1[0], r0[1], r1[1]};
}
struct NoPre {};
struct EpiInProj {
    typedef NoPre Pre; __device__ __forceinline__ void prefetch(const Unit&, int, int, int, int, Pre&) const {}
    static constexpr bool PERM = true;
    bf16_t* slots; const float* rs1; float* out; int seg;
    __device__ __forceinline__ void operator()(Acc& acc, const Unit& u, int wr, int wc, int fr, int fq, const Pre& pre) const {
        const int pn = u.pn, row0 = u.pm * BM + wr * 64 + fr;
        const bool ptile = (pn >= 16 && pn < 20) || (pn >= 24 && pn < 28), gtile = pn >= 28;
        if (ptile) {
            const int q = pn < 20 ? pn - 16 : pn - 20, col0 = q * HALF + wc * 32 + 8 * fq;
            bf16_t* base = slots + (size_t)4 * ((size_t)MS * D);
#pragma unroll
            for (int ai = 0; ai < 2; ++ai)
#pragma unroll
                for (int m = 0; m < 4; ++m) { const f32x4 v0 = acc[ai][0][m][0] * acc[ai][1][m][0], v1 = acc[ai][0][m][1] * acc[ai][1][m][1];
                    u32x4 w; w.x = cvt_pk_bf16(v0[0], v0[1]); w.y = cvt_pk_bf16(v0[2], v0[3]); w.z = cvt_pk_bf16(v1[0], v1[1]); w.w = cvt_pk_bf16(v1[2], v1[3]);
                    *(u32x4*)(base + (size_t)(row0 + ai * HALF + m * 16) * D + col0) = w; }
        } else if (gtile) {
            const int col0 = (pn - 28) * HALF + wc * 32 + 8 * fq;
            bf16_t* bA = (bf16_t*)out; bf16_t* bB = slots + (size_t)8 * ((size_t)MS * D);
#pragma unroll
            for (int ai = 0; ai < 2; ++ai)
#pragma unroll
                for (int m = 0; m < 4; ++m) { const size_t off = (size_t)(row0 + ai * HALF + m * 16) * D + col0;
                    f32x4 r0, r1, b0, b1;
#pragma unroll
                    for (int j = 0; j < 4; ++j) { b0[j] = sigmoidf_(acc[ai][1][m][0][j]); b1[j] = sigmoidf_(acc[ai][1][m][1][j]);
                        r0[j] = sigmoidf_(acc[ai][0][m][0][j]) * __builtin_amdgcn_rcpf(1e-20f + b0[j]); r1[j] = sigmoidf_(acc[ai][0][m][1][j]) * __builtin_amdgcn_rcpf(1e-20f + b1[j]); }
                    u32x4 w; w.x = cvt_pk_bf16(r0[0], r0[1]); w.y = cvt_pk_bf16(r0[2], r0[3]); w.z = cvt_pk_bf16(r1[0], r1[1]); w.w = cvt_pk_bf16(r1[2], r1[3]);
                    *(u32x4*)(bA + (size_t)grow(seg, row0 + ai * HALF + m * 16) * (2 * D) + col0) = w;
                    w.x = cvt_pk_bf16(b0[0], b0[1]); w.y = cvt_pk_bf16(b0[2], b0[3]); w.z = cvt_pk_bf16(b1[0], b1[1]); w.w = cvt_pk_bf16(b1[2], b1[3]);
                    *(u32x4*)(bB + off) = w; }
        } else {
            const int arr = pn >> 2, col0 = (pn & 3) * BM + wc * 32 + 8 * fq;
            bf16_t* base = slots + (size_t)arr * ((size_t)MS * D);
#pragma unroll
            for (int ai = 0; ai < 2; ++ai)
#pragma unroll
                for (int m = 0; m < 4; ++m) { const int row = row0 + ai * HALF + m * 16; bf16_t* rowp = base + (size_t)row * D + col0;
#pragma unroll
                    for (int bj = 0; bj < 2; ++bj) { const f32x4 v0 = acc[ai][bj][m][0], v1 = acc[ai][bj][m][1];
                        u32x4 w; w.x = cvt_pk_bf16(v0[0], v0[1]); w.y = cvt_pk_bf16(v0[2], v0[3]); w.z = cvt_pk_bf16(v1[0], v1[1]); w.w = cvt_pk_bf16(v1[2], v1[3]);
                        *(u32x4*)(rowp + bj * HALF) = w; } }
        }
    }
};
struct SchedMerge : Order {
    static constexpr bool GATHER = false; static constexpr int ROWB = 1024;
    const char* A0; const char* B0; const char* A1; const char* B1;
    __device__ __forceinline__ bool next(int i, Unit& u) const { const bool ok = Order::next(i >> 1, u); u.part = i & 1; return ok; }
    __device__ __forceinline__ const char* a_tile(const Unit& u) const { return (u.part ? A1 : A0) + (size_t)u.pm * (BM * ROWB); }
    __device__ __forceinline__ const char* b_tile(const Unit& u) const { return (u.part ? B1 : B0) + (size_t)u.pn * (BM * ROWB); }
    __device__ __forceinline__ void a_offs(const Unit&, const int (&R)[2], const int (&C)[2], unsigned (&o)[2][2]) const {
#pragma unroll
        for (int h = 0; h < 2; ++h)
#pragma unroll
            for (int i = 0; i < 2; ++i) o[h][i] = (unsigned)((h * HALF + R[i]) * ROWB + C[i] * 2);
    }
};
struct EpiMerge {
    typedef NoPre Pre; __device__ __forceinline__ void prefetch(const Unit&, int, int, int, int, Pre&) const {}
    static constexpr bool PERM = true, KEEP = true;
    bf16_t* out; const bf16_t* gA; const bf16_t* gB; int seg;
    __device__ __forceinline__ void operator()(Acc& acc, const Unit& u, int wr, int wc, int fr, int fq, const Pre&) const {
        const int col0 = u.pn * BM + wc * 32 + 8 * fq, row0 = u.pm * BM + wr * 64 + fr;
        if (u.part == 0) {
#pragma unroll
            for (int ai = 0; ai < 2; ++ai)
#pragma unroll
                for (int m = 0; m < 4; ++m) { const size_t off = (size_t)grow(seg, row0 + ai * HALF + m * 16) * (2 * D) + col0;
#pragma unroll
                    for (int bj = 0; bj < 2; ++bj) { const u32x4 a = *(const u32x4*)(gA + off + bj * HALF);
                        f32x4& v0 = acc[ai][bj][m][0]; f32x4& v1 = acc[ai][bj][m][1];
                        v0[0] *= bflo(a.x); v0[1] *= bfhi(a.x); v0[2] *= bflo(a.y); v0[3] *= bfhi(a.y); v1[0] *= bflo(a.z); v1[1] *= bfhi(a.z); v1[2] *= bflo(a.w); v1[3] *= bfhi(a.w); }
                    if (m & 1) asm volatile("" ::: "memory"); }
        } else {
#pragma unroll
            for (int ai = 0; ai < 2; ++ai)
#pragma unroll
                for (int m = 0; m < 4; ++m) { const size_t off = (size_t)(row0 + ai * HALF + m * 16) * D + col0;
#pragma unroll
                    for (int bj = 0; bj < 2; ++bj) { const u32x4 g = *(const u32x4*)(gB + off + bj * HALF);
                        f32x4 v0 = acc[ai][bj][m][0], v1 = acc[ai][bj][m][1];
                        v0[0] *= bflo(g.x); v0[1] *= bfhi(g.x); v0[2] *= bflo(g.y); v0[3] *= bfhi(g.y); v1[0] *= bflo(g.z); v1[1] *= bfhi(g.z); v1[2] *= bflo(g.w); v1[3] *= bfhi(g.w);
                        u32x4 w; w.x = cvt_pk_bf16(v0[0], v0[1]); w.y = cvt_pk_bf16(v0[2], v0[3]); w.z = cvt_pk_bf16(v1[0], v1[1]); w.w = cvt_pk_bf16(v1[2], v1[3]);
                        *(u32x4*)(out + off + bj * HALF) = w; }
                    if (m & 1) asm volatile("" ::: "memory"); }
        }
    }
};
struct EpiMix {
    typedef NoPre Pre; __device__ __forceinline__ void prefetch(const Unit&, int, int, int, int, Pre&) const {}
    static constexpr bool PERM = true, TINIT = true;
    const bf16_t* xb; const float* rs1; float* out; int seg;
    __device__ __forceinline__ void tile_load(const Unit& u, int wr, int wc, int fr, int fq, TReg& t) const {
        const int col0 = u.pn * BM + wc * 32 + 8 * fq, row0 = u.pm * BM + wr * 64 + fr;
#pragma unroll
        for (int ai = 0; ai < 2; ++ai)
#pragma unroll
            for (int m = 0; m < 4; ++m) { const int row = row0 + ai * HALF + m * 16; t.inv[ai][m] = rs1[row];
#pragma unroll
                for (int bj = 0; bj < 2; ++bj) t.x[ai][m][bj] = *(const u32x4*)(xb + (size_t)row * D + col0 + bj * HALF); }
    }
    __device__ __forceinline__ void operator()(Acc& acc, const Unit& u, int wr, int wc, int fr, int fq, const Pre& pre) const {
        const int col0 = u.pn * BM + wc * 32 + 8 * fq, row0 = u.pm * BM + wr * 64 + fr;
#pragma unroll
        for (int ai = 0; ai < 2; ++ai)
#pragma unroll
            for (int m = 0; m < 4; ++m) { const int row = row0 + ai * HALF + m * 16; bf16_t* hr = (bf16_t*)out + (size_t)grow(seg, row) * (2 * D) + col0;
#pragma unroll
                for (int bj = 0; bj < 2; ++bj) { const f32x4 v0 = acc[ai][bj][m][0], v1 = acc[ai][bj][m][1];
                    u32x4 w; w.x = cvt_pk_bf16(v0[0], v0[1]); w.y = cvt_pk_bf16(v0[2], v0[3]); w.z = cvt_pk_bf16(v1[0], v1[1]); w.w = cvt_pk_bf16(v1[2], v1[3]);
                    *(u32x4*)(hr + bj * HALF) = w; } }
    }
};
struct EpiMoe1 {
    typedef NoPre Pre; __device__ __forceinline__ void prefetch(const Unit&, int, int, int, int, Pre&) const {}
    static constexpr bool PERM = true, BINIT = true;
    unsigned char* hid; const LAS int* tile_e; const bf16_t* bgu;
    __device__ __forceinline__ void bias_load(const Unit& u, int wr, int wc, int fr, int fq, BReg& r) const {
        const int e = __builtin_amdgcn_readfirstlane(tile_e[u.pm]); const bf16_t* bgp = bgu + (size_t)e * 2048 + u.pn * HALF + wc * 32 + 8 * fq;
        r.b[0] = *(const u32x4*)bgp; r.b[1] = *(const u32x4*)(bgp + 1024);
    }
    __device__ __forceinline__ void operator()(Acc& acc, const Unit& u, int wr, int wc, int fr, int fq, const Pre&) const {
        const int row0 = u.pm * BM + wr * 64 + fr;
#pragma unroll
        for (int ai = 0; ai < 2; ++ai) { u32x2 w[4];
#pragma unroll
            for (int m = 0; m < 4; ++m) {
                const f32x4 g0 = acc[ai][0][m][0], g1 = acc[ai][0][m][1], u0 = acc[ai][1][m][0], u1 = acc[ai][1][m][1];
                f32x4 h0, h1;
#pragma unroll
                for (int j = 0; j < 4; ++j) {
                    const float ga = fminf(g0[j], 7.0f), gb = fminf(g1[j], 7.0f);
                    const float ua = __builtin_amdgcn_fmed3f(u0[j], -7.0f, 7.0f), ub = __builtin_amdgcn_fmed3f(u1[j], -7.0f, 7.0f);
                    h0[j] = __builtin_fmaf(ua, ga, ga) * __builtin_amdgcn_rcpf(1.0f + __builtin_amdgcn_exp2f(ga * -2.45546696f));
                    h1[j] = __builtin_fmaf(ub, gb, gb) * __builtin_amdgcn_rcpf(1.0f + __builtin_amdgcn_exp2f(gb * -2.45546696f)); }
                w[m].x = cvt_pk4_fp8(h0[0], h0[1], h0[2], h0[3]); w[m].y = cvt_pk4_fp8(h1[0], h1[1], h1[2], h1[3]); }
#pragma unroll
            for (int mp = 0; mp < 2; ++mp) *(u32x4*)(hid + (size_t)(row0 + 16 * (fq & 1) + ai * HALF + mp * 32) * D + u.pn * HALF + wc * 32 + 8 * (fq & 2)) = widen16(w[2 * mp], w[2 * mp + 1]); }
    }
};
struct EpiMoe2 {
    typedef NoPre Pre; __device__ __forceinline__ void prefetch(const Unit&, int, int, int, int, Pre&) const {}
    static constexpr bool PERM = true, BINIT = true;
    unsigned char* y; const LAS int* tile_e; const bf16_t* bdn;
    __device__ __forceinline__ void bias_load(const Unit& u, int wr, int wc, int fr, int fq, BReg& r) const {
        const int e = __builtin_amdgcn_readfirstlane(tile_e[u.pm]); const int col0 = u.pn * BM + wc * 32 + 8 * fq;
#pragma unroll
        for (int bj = 0; bj < 2; ++bj) r.b[bj] = *(const u32x4*)(bdn + (size_t)e * D + col0 + bj * HALF);
    }
    __device__ __forceinline__ void operator()(Acc& acc, const Unit& u, int wr, int wc, int fr, int fq, const Pre&) const {
        const int colw = u.pn * BM + wc * 32 + 8 * (fq & 2), row0 = u.pm * BM + wr * 64 + fr + 16 * (fq & 1);
#pragma unroll
        for (int ai = 0; ai < 2; ++ai)
#pragma unroll
            for (int bj = 0; bj < 2; ++bj) { u32x2 w[4];
#pragma unroll
                for (int m = 0; m < 4; ++m) { const f32x4 v0 = acc[ai][bj][m][0], v1 = acc[ai][bj][m][1]; w[m].x = cvt_pk4_fp8(v0[0], v0[1], v0[2], v0[3]); w[m].y = cvt_pk4_fp8(v1[0], v1[1], v1[2], v1[3]); }
#pragma unroll
                for (int mp = 0; mp < 2; ++mp) *(u32x4*)(y + (size_t)(row0 + ai * HALF + mp * 32) * D + colw + bj * HALF) = widen16(w[2 * mp], w[2 * mp + 1]); }
    }
};
}

#ifndef PG8_SP2
#define PG8_SP2 true
#endif
#ifndef PG8_ALIGN
#define PG8_ALIGN true
#endif

struct Args { const float* in[19]; float* out; unsigned char* ws; int do_pro, seg_lo, seg_hi, ph_lo, ph_hi, pad; };
enum { I_X = 0, I_NMG, I_WIN, I_CONVW, I_ALOG, I_DTB, I_GNG, I_WOG, I_SCW, I_WOS, I_WMX, I_NFG, I_WR, I_BR, I_WGU, I_BGU, I_WDN, I_BDN, I_NFIN };

typedef const __attribute__((address_space(4))) Args* KArgsP;
__device__ __forceinline__ Args load_args() {
#if defined(__HIP_DEVICE_COMPILE__)
    KArgsP p = (KArgsP)__builtin_amdgcn_kernarg_segment_ptr(); asm volatile("" : "+s"(p)); return *p;
#else
    return Args{};
#endif
}
__device__ __forceinline__ void tr_item(const float* __restrict__ src, int ld, int c0, const float* __restrict__ scale, bf16_t* dst, int k0, LAS float* scr, int lane) {
#pragma unroll 8
    for (int i = 0; i < 32; ++i) { const int kk = 2 * i + (lane >> 5); float v = src[(size_t)(k0 + kk) * ld + c0 + (lane & 31)]; if (scale) v *= scale[k0 + kk]; scr[kk * 33 + (lane & 31)] = v; }
    LDS_WAIT();
    const int c = lane & 7;
#pragma unroll
    for (int j = 0; j < 4; ++j) { const int n = (lane >> 3) + 8 * j; const LAS float* s = scr + (8 * c) * 33 + n;
        u32x4 o; o.x = cvt_pk_bf16(s[0 * 33], s[1 * 33]); o.y = cvt_pk_bf16(s[2 * 33], s[3 * 33]); o.z = cvt_pk_bf16(s[4 * 33], s[5 * 33]); o.w = cvt_pk_bf16(s[6 * 33], s[7 * 33]);
        *(u32x4*)(dst + (size_t)n * 1024 + k0 + 8 * c) = o; }
    LDS_WAIT();
}
template <bool FP8OUT>
__device__ __forceinline__ void tr_item64(const float* __restrict__ src, int ld, int c0, const float* __restrict__ scale, float mul, unsigned char* dst, int k0, LAS float* scr, int lane) {
    const int nl = (lane & 15) * 4, kl = lane >> 4;
    f32x4 v[8];
#pragma unroll
    for (int i = 0; i < 8; ++i) v[i] = *(const f32x4*)(src + (size_t)(k0 + 4 * i + kl) * ld + c0 + nl);
#pragma unroll
    for (int i = 0; i < 8; ++i) { const int kk = 4 * i + kl; const float sc = scale ? scale[k0 + kk] * mul : mul;
#pragma unroll
        for (int j = 0; j < 4; ++j) scr[kk * 65 + nl + j] = v[i][j] * sc; }
    LDS_WAIT();
#pragma unroll
    for (int t = 0; t < 4; ++t) { const int task = t * 64 + lane, n = task >> 2, c = task & 3; const LAS float* sp = scr + (8 * c) * 65 + n;
        if constexpr (FP8OUT) { u32x2 o; o.x = cvt_pk4_fp8(sp[0], sp[65], sp[130], sp[195]); o.y = cvt_pk4_fp8(sp[260], sp[325], sp[390], sp[455]); *(u32x2*)(dst + (size_t)n * 1024 + k0 + 8 * c) = o; }
        else { u32x4 o; o.x = cvt_pk_bf16(sp[0], sp[65]); o.y = cvt_pk_bf16(sp[130], sp[195]); o.z = cvt_pk_bf16(sp[260], sp[325]); o.w = cvt_pk_bf16(sp[390], sp[455]); *(u32x4*)(dst + (size_t)n * 2048 + (k0 + 8 * c) * 2) = o; } }
    LDS_WAIT();
}
template <int NSUB>
__device__ __forceinline__ void tr_run64_fp8(const float* __restrict__ src, int ld, int c0, const float* __restrict__ scale, float mul, unsigned char* dst, int k0, LAS float* scr, int lane) {
    const int nl = (lane & 15) * 4, kl = lane >> 4;
    const float* p = src + (size_t)(k0 + kl) * ld + c0 + nl;
    f32x4 v[8];
#pragma unroll
    for (int i = 0; i < 8; ++i) v[i] = *(const f32x4*)(p + (size_t)(4 * i) * ld);
#pragma unroll
    for (int sb = 0; sb < NSUB; ++sb) {
        const int kb = k0 + 32 * sb;
#pragma unroll
        for (int i = 0; i < 8; ++i) { const int kk = 4 * i + kl; const float sc = scale ? scale[kb + kk] * mul : mul;
#pragma unroll
            for (int j = 0; j < 4; ++j) scr[kk * 65 + nl + j] = v[i][j] * sc; }
        if (sb + 1 < NSUB) {
#pragma unroll
            for (int i = 0; i < 8; ++i) v[i] = *(const f32x4*)(p + (size_t)(32 * (sb + 1) + 4 * i) * ld); }
        LDS_WAIT();
#pragma unroll
        for (int t = 0; t < 2; ++t) { const int task = t * 64 + lane, n = task >> 1, c = task & 1; const LAS float* sp = scr + (16 * c) * 65 + n;
            u32x4 o; o.x = cvt_pk4_fp8(sp[0], sp[65], sp[130], sp[195]); o.y = cvt_pk4_fp8(sp[260], sp[325], sp[390], sp[455]);
            o.z = cvt_pk4_fp8(sp[520], sp[585], sp[650], sp[715]); o.w = cvt_pk4_fp8(sp[780], sp[845], sp[910], sp[975]);
            *(u32x4*)(dst + (size_t)n * 1024 + kb + 16 * c) = o; }
        LDS_WAIT();
    }
}
__device__ __forceinline__ void phase_prep(const Args& a, LAS unsigned char* lds) {
    const int wave = wave_id(), lane = threadIdx.x & 63;
    LAS float* scr = (LAS float*)(lds + wave * 8448);
    unsigned char* ws = a.ws;
    constexpr int I_IN = 32 * 144, I_SQ = 32 * 16, U_GU = 32 * 8 * 32, U_DN = 32 * 8 * 16, I_AB = 16, I_R = 16;
    constexpr int NIT = I_IN + 3 * I_SQ + I_AB + I_R;
    const int gw = blockIdx.x * 8 + wave, NGW = gridDim.x * 8;
    for (int i = gw * 64 + lane; i < NE * 2048 / 2; i += NGW * 64) ((unsigned*)(ws + WS_BGU16))[i] = cvt_pk_bf16(a.in[I_BGU][2 * i], a.in[I_BGU][2 * i + 1]);
    for (int i = gw * 64 + lane; i < NE * 1024 / 2; i += NGW * 64) ((unsigned*)(ws + WS_BDN16))[i] = cvt_pk_bf16(a.in[I_BDN][2 * i], a.in[I_BDN][2 * i + 1]);
    for (int u = gw; u < U_GU + U_DN; u += NGW) {
        if (u < U_GU) { const int e = u >> 8, kq = (u >> 5) & 7, nb = u & 31, n0 = nb * 64, pn = n0 >> 8, bj = (n0 >> 7) & 1, j0 = n0 & 127, c0 = bj * 1024 + pn * 128 + j0;
            tr_run64_fp8<4>(a.in[I_WGU] + (size_t)e * 1024 * 2048, 2048, c0, a.in[I_NFG], 32.0f, ws + WS_WGU + ((size_t)e * 2048 + n0) * 1024, kq * 128, scr, lane); }
        else { const int r = u - U_GU, e = r >> 7, kq = (r >> 4) & 7, nb = r & 15;
            tr_run64_fp8<4>(a.in[I_WDN] + (size_t)e * 1024 * 1024, 1024, nb * 64, nullptr, 32.0f, ws + WS_WDN + ((size_t)e * 1024 + nb * 64) * 1024, kq * 128, scr, lane); }
    }
    for (int it = gw; it < NIT; it += NGW) {
        int r = it;
        if (r < I_IN) { const int kb = r / 144, nb = r % 144, n0 = nb * 64;
            int lc = n0; { const int pn = n0 >> 8, hf = (n0 >> 7) & 1, j = n0 & 127;
                if ((pn >= 16 && pn < 20) || (pn >= 24 && pn < 28)) lc = (hf ? 6 : 4) * 1024 + (pn < 20 ? pn - 16 : pn - 20) * 128 + j;
                else if (pn >= 28) lc = (hf ? 8 : 7) * 1024 + (pn - 28) * 128 + j; }
            const int c0 = lc < 4096 ? lc : lc + 16;
            tr_item64<false>(a.in[I_WIN], DIN, c0, a.in[I_NMG], 1.0f, ws + WS_WIN + (size_t)n0 * 2048, kb * 32, scr, lane); continue; } r -= I_IN;
        if (r < I_SQ) { const int kb = r >> 4, nb = r & 15; tr_item64<true>(a.in[I_WOG], 1024, nb * 64, nullptr, 32.0f, ws + WS_WOG + (size_t)nb * 64 * 1024, kb * 32, scr, lane); continue; } r -= I_SQ;
        if (r < I_SQ) { const int kb = r >> 4, nb = r & 15; tr_item64<true>(a.in[I_WOS], 1024, nb * 64, nullptr, 32.0f, ws + WS_WOS + (size_t)nb * 64 * 1024, kb * 32, scr, lane); continue; } r -= I_SQ;
        if (r < I_SQ) { const int kb = r >> 4, nb = r & 15; tr_item64<false>(a.in[I_WMX], 1024, nb * 64, nullptr, 1.0f, ws + WS_WMX + (size_t)nb * 64 * 2048, kb * 32, scr, lane); continue; } r -= I_SQ;
        if (r < I_AB) { tr_item(a.in[I_WIN], DIN, 4096, a.in[I_NMG], (bf16_t*)(ws + WS_WAB), r * 64, scr, lane); continue; } r -= I_AB;
        tr_item(a.in[I_WR], 32, 0, a.in[I_NFG], (bf16_t*)(ws + WS_WR), r * 64, scr, lane);
    }
}

__device__ __forceinline__ void phase_cast(const Args& a, int seg) {
    const int wave = wave_id(), lane = threadIdx.x & 63;
    unsigned char* ws = a.ws;
    const float* x = a.in[I_X]; bf16_t* xb = (bf16_t*)(ws + WS_SLOTS + 9 * SLOT); const bf16_t* wab = (const bf16_t*)(ws + WS_WAB);
    float* rs1 = (float*)(ws + WS_RS1); float* gb = (float*)(ws + WS_GB);
    const int gw = blockIdx.x * 8 + wave, NGW = gridDim.x * 8, tk = lane & 15, quad = lane >> 4;
    for (int grp = gw; grp < MS / 16; grp += NGW) {
        const int r = grp * 16 + tk; const int Rg = grow(seg, r);
        const float* xr = x + (size_t)Rg * D + quad * 8; bf16_t* xo = xb + (size_t)r * D + quad * 8; const bf16_t* wr_ = wab + (size_t)tk * D + quad * 8;
        f32x4 acc = {0.f, 0.f, 0.f, 0.f}; float ss = 0.f;
        u32x4 keep[32];
#pragma unroll
        for (int ks = 0; ks < 32; ++ks) {
            const f32x4 v0 = *(const f32x4*)(xr + ks * 32), v1 = *(const f32x4*)(xr + ks * 32 + 4);
            ss += (v0[0] * v0[0] + v0[1] * v0[1]) + (v0[2] * v0[2] + v0[3] * v0[3]) + (v1[0] * v1[0] + v1[1] * v1[1]) + (v1[2] * v1[2] + v1[3] * v1[3]);
            keep[ks].x = cvt_pk_bf16(v0[0], v0[1]); keep[ks].y = cvt_pk_bf16(v0[2], v0[3]); keep[ks].z = cvt_pk_bf16(v1[0], v1[1]); keep[ks].w = cvt_pk_bf16(v1[2], v1[3]);
        }
        ss += __shfl_xor(ss, 16); ss += __shfl_xor(ss, 32);
        const float rs = 1.0f / sqrtf(ss * (1.0f / D) + EPS);
#pragma unroll
        for (int ks = 0; ks < 32; ++ks) {
            const u32x4 k = keep[ks];
            u32x4 p; p.x = cvt_pk_bf16(bflo(k.x) * rs, bfhi(k.x) * rs); p.y = cvt_pk_bf16(bflo(k.y) * rs, bfhi(k.y) * rs); p.z = cvt_pk_bf16(bflo(k.z) * rs, bfhi(k.z) * rs); p.w = cvt_pk_bf16(bflo(k.w) * rs, bfhi(k.w) * rs);
            *(u32x4*)(xo + ks * 32) = p;
            const bf16x8 wf = *(const bf16x8*)(wr_ + ks * 32);
            acc = __builtin_amdgcn_mfma_f32_16x16x32_bf16(wf, __builtin_bit_cast(bf16x8, p), acc, 0, 0, 0);
        }
        f32x4 o;
#pragma unroll
        for (int j = 0; j < 4; ++j) {
            const int n = quad * 4 + j; const float v = acc[j];
            if (quad < 2) { const float t = v + a.in[I_DTB][n]; const float sp = t > 20.f ? t : log1pf(expf(t)); o[j] = -expf(a.in[I_ALOG][n]) * sp; }
            else o[j] = 1.0f / (1.0f + expf(-v));
        }
        *(f32x4*)(gb + (size_t)r * 16 + quad * 4) = o;
        if (quad == 0) rs1[r] = rs;
    }
}

__device__ __forceinline__ void ld8(const bf16_t* p, float (&v)[8]) { const u32x4 w = *(const u32x4*)p; v[0] = bflo(w.x); v[1] = bfhi(w.x); v[2] = bflo(w.y); v[3] = bfhi(w.y); v[4] = bflo(w.z); v[5] = bfhi(w.z); v[6] = bflo(w.w); v[7] = bfhi(w.w); }
__device__ __forceinline__ void st8(bf16_t* p, const float (&v)[8]) { u32x4 w; w.x = cvt_pk_bf16(v[0], v[1]); w.y = cvt_pk_bf16(v[2], v[3]); w.z = cvt_pk_bf16(v[4], v[5]); w.w = cvt_pk_bf16(v[6], v[7]); *(u32x4*)p = w; }
__device__ __forceinline__ void st8_fp8(unsigned char* p, const float (&v)[8]) { u32x2 w; w.x = cvt_pk4_fp8(sat8(v[0]), sat8(v[1]), sat8(v[2]), sat8(v[3])); w.y = cvt_pk4_fp8(sat8(v[4]), sat8(v[5]), sat8(v[6]), sat8(v[7])); *(u32x2*)p = w; }
__device__ __forceinline__ void ldf8(const float* p, float (&v)[8]) { const f32x4 a = *(const f32x4*)p, b = *(const f32x4*)(p + 4); v[0] = a[0]; v[1] = a[1]; v[2] = a[2]; v[3] = a[3]; v[4] = b[0]; v[5] = b[1]; v[6] = b[2]; v[7] = b[3]; }
__device__ __forceinline__ void up8(const u32x4 w, float (&v)[8]) { v[0] = bflo(w.x); v[1] = bfhi(w.x); v[2] = bflo(w.y); v[3] = bfhi(w.y); v[4] = bflo(w.z); v[5] = bfhi(w.z); v[6] = bflo(w.w); v[7] = bfhi(w.w); }
constexpr int TBK = 32;
__device__ __forceinline__ void phase_sconv(const Args& a, int seg) {
    const int wave = wave_id(), lane = threadIdx.x & 63;
    unsigned char* ws = a.ws;
    const bf16_t* PS = (const bf16_t*)(ws + WS_SLOTS + 4 * SLOT); const bf16_t* Bg = (const bf16_t*)(ws + WS_SLOTS + 5 * SLOT);
    unsigned char* U = ws + WS_SLOTS + 10 * SLOT; bf16_t* halo = (bf16_t*)(ws + WS_HALOS);
    const int gw = blockIdx.x * 8 + wave, NGW = gridDim.x * 8;
    constexpr int NTB = L / TBK, NU = NB * NTB * 2;
    for (int un = gw; un < NU; un += NGW) {
        const int sl = un & 1, tb = (un >> 1) % NTB, b = (un >> 1) / NTB, ch = sl * 512 + lane * 8, tl0 = tb * TBK;
        float w0[8], w1[8], w2[8]; ldf8(a.in[I_SCW] + ch, w0); ldf8(a.in[I_SCW] + 1024 + ch, w1); ldf8(a.in[I_SCW] + 2048 + ch, w2);
        float p2[8], p1[8];
        if (tl0 > 0) { const size_t o2 = (size_t)(b * L + tl0 - 2) * D + ch; ld8(PS + o2, p2); ld8(PS + o2 + D, p1); }
        else if (seg > 0) { const bf16_t* hp = halo + ((size_t)(((seg - 1) & 1) * 16 + b) * 2) * 1024 + ch; ld8(hp, p2); ld8(hp + 1024, p1); }
        else {
#pragma unroll
            for (int i = 0; i < 8; ++i) { p2[i] = 0.f; p1[i] = 0.f; } }
#pragma unroll 1
        for (int t0 = 0; t0 < TBK; t0 += 4) {
            u32x4 pw[4], bw[4];
#pragma unroll
            for (int q = 0; q < 4; ++q) { const size_t o = (size_t)(b * L + tl0 + t0 + q) * D + ch; pw[q] = *(const u32x4*)(PS + o); bw[q] = *(const u32x4*)(Bg + o); }
#pragma unroll
            for (int q = 0; q < 4; ++q) { const size_t o = (size_t)(b * L + tl0 + t0 + q) * D + ch; float pa[8], ba[8], r[8]; up8(pw[q], pa); up8(bw[q], ba);
#pragma unroll
                for (int i = 0; i < 8; ++i) { const float p = pa[i]; r[i] = ba[i] * (w0[i] * p2[i] + w1[i] * p1[i] + w2[i] * p); p2[i] = p1[i]; p1[i] = p; }
                st8_fp8(U + o, r); }
        }
        if (tl0 + TBK == L) { bf16_t* hp = halo + ((size_t)((seg & 1) * 16 + b) * 2) * 1024 + ch; st8(hp, p2); st8(hp + 1024, p1); }
    }
}

__device__ __forceinline__ void phase_qkvconv(const Args& a, int seg) {
    const int wave = wave_id(), lane = threadIdx.x & 63;
    unsigned char* ws = a.ws;
    bf16_t* halo = (bf16_t*)(ws + WS_HALOQ);
    const int gw = blockIdx.x * 8 + wave, NGW = gridDim.x * 8;
    constexpr int NTB = L / TBK, NU = NB * NTB * 6;
    for (int un = gw; un < NU; un += NGW) {
        const int sl = un % 6, tb = (un / 6) % NTB, b = (un / 6) / NTB, arr = sl >> 1, ch = (sl & 1) * 512 + lane * 8, tl0 = tb * TBK;
        const bf16_t* src = (const bf16_t*)(ws + WS_SLOTS + (size_t)arr * SLOT); bf16_t* dst = arr == 0 ? (bf16_t*)(ws + WS_QC) : (bf16_t*)(ws + WS_SLOTS + (size_t)(arr == 1 ? 7 : 6) * SLOT);
        const float* cw = a.in[I_CONVW] + arr * 1024 + ch;
        float w0[8], w1[8], w2[8], w3[8]; ldf8(cw, w0); ldf8(cw + 3072, w1); ldf8(cw + 2 * 3072, w2); ldf8(cw + 3 * 3072, w3);
        float h3[8], h2[8], h1[8];
        if (tl0 > 0) { const size_t o3 = (size_t)(b * L + tl0 - 3) * D + ch; ld8(src + o3, h3); ld8(src + o3 + D, h2); ld8(src + o3 + 2 * D, h1); }
        else if (seg > 0) { const bf16_t* hp = halo + ((size_t)(((seg - 1) & 1) * 16 + b) * 3) * 3072 + arr * 1024 + ch; ld8(hp, h3); ld8(hp + 3072, h2); ld8(hp + 2 * 3072, h1); }
        else {
#pragma unroll
            for (int i = 0; i < 8; ++i) { h3[i] = 0.f; h2[i] = 0.f; h1[i] = 0.f; } }
#pragma unroll 1
        for (int t0 = 0; t0 < TBK; t0 += 8) {
            u32x4 cwv[8];
#pragma unroll
            for (int q = 0; q < 8; ++q) cwv[q] = *(const u32x4*)(src + (size_t)(b * L + tl0 + t0 + q) * D + ch);
#pragma unroll
            for (int q = 0; q < 8; ++q) { const size_t o = (size_t)(b * L + tl0 + t0 + q) * D + ch; float c[8], r[8]; up8(cwv[q], c);
                float ss = 0.f;
#pragma unroll
                for (int i = 0; i < 8; ++i) { const float y = w0[i] * h3[i] + w1[i] * h2[i] + w2[i] * h1[i] + w3[i] * c[i]; const float sv = y * sigmoidf_(y); r[i] = sv; ss += sv * sv; h3[i] = h2[i]; h2[i] = h1[i]; h1[i] = c[i]; }
                if (arr < 2) {
                    ss += __shfl_xor(ss, 1); ss += __shfl_xor(ss, 2); ss += __shfl_xor(ss, 4); ss += __shfl_xor(ss, 8);
                    float sc = 1.0f / sqrtf(ss + EPS); if (arr == 0) sc *= 0.08838834764831845f;
#pragma unroll
                    for (int i = 0; i < 8; ++i) r[i] *= sc;
                }
                st8(dst + o, r); }
        }
        if (tl0 + TBK == L) { bf16_t* hp = halo + ((size_t)((seg & 1) * 16 + b) * 3) * 3072 + arr * 1024 + ch; st8(hp, h3); st8(hp + 3072, h2); st8(hp + 2 * 3072, h1); }
    }
}

typedef short s16x4 __attribute__((ext_vector_type(4)));
constexpr int HREC = 5888, HR_T2 = 4096, HR_HP = 5120, HR_HT = 5632;
constexpr int NCH = MS / 16;
static_assert((size_t)NCH * NH * HREC <= 3 * SLOT, "hand-over records overlay the dead raw q|k|v slots");
__device__ __forceinline__ bf16x8 tr_frag8(const LAS unsigned char* p0, const LAS unsigned char* p1) {
    const s16x4 a = __builtin_amdgcn_ds_read_tr16_b64_v4i16((LAS s16x4*)p0), b = __builtin_amdgcn_ds_read_tr16_b64_v4i16((LAS s16x4*)p1);
    return __builtin_shufflevector(a, b, 0, 1, 2, 3, 4, 5, 6, 7);
}
__device__ __forceinline__ void phase_gdnprep(const Args& a, LAS unsigned char* lds) {
    const int wave = wave_id(), lane = threadIdx.x & 63, li = lane & 15, quad = lane >> 4, tq = li >> 2, tp = li & 3;
    unsigned char* ws = a.ws;
    const bf16_t* Q = (const bf16_t*)(ws + WS_QC); const bf16_t* Kc = (const bf16_t*)(ws + WS_SLOTS + 7 * SLOT);
    const float* gb = (const float*)(ws + WS_GB); unsigned char* hbase = ws + WS_SLOTS;
    LAS unsigned char* wl = lds + wave * 10240;
    LAS unsigned char* Ki = wl; LAS float* Lt = (LAS float*)(wl + 8192); LAS float* tab = (LAS float*)(wl + 8192 + 1280);
    const int gw = blockIdx.x * 8 + wave, NGW = gridDim.x * 8;
    for (int task = gw; task < NCH * NH; task += NGW) {
        const int ci = task >> 3, h = task & 7, r0 = ci * 16;
        const float gv = gb[(size_t)(r0 + li) * 16 + h], bv = gb[(size_t)(r0 + li) * 16 + 8 + h];
        float G = gv;
#pragma unroll
        for (int o = 1; o < 16; o <<= 1) { const float t = __shfl_up(G, o, 16); if (li >= o) G += t; }
        const float Gl = __shfl(G, 15, 16);
        const size_t rowoff = (size_t)(r0 + li) * D + h * HD + quad * 8;
        bf16x8 kf[4], qf[4];
#pragma unroll
        for (int ks = 0; ks < 4; ++ks) { kf[ks] = *(const bf16x8*)(Kc + rowoff + ks * 32); qf[ks] = *(const bf16x8*)(Q + rowoff + ks * 32); }
#pragma unroll
        for (int ks = 0; ks < 4; ++ks) *(LAS bf16x8*)(Ki + li * 256 + (((4 * ks + quad) ^ li) << 4)) = kf[ks];
        f32x4 accK = {0.f, 0.f, 0.f, 0.f}, accP = {0.f, 0.f, 0.f, 0.f};
#pragma unroll
        for (int ks = 0; ks < 4; ++ks) { accK = __builtin_amdgcn_mfma_f32_16x16x32_bf16(kf[ks], kf[ks], accK, 0, 0, 0); accP = __builtin_amdgcn_mfma_f32_16x16x32_bf16(kf[ks], qf[ks], accP, 0, 0, 0); }
        unsigned char* rec = hbase + (size_t)task * HREC;
        float Gq[4], Bq[4];
#pragma unroll
        for (int r = 0; r < 4; ++r) { Gq[r] = __shfl(G, 4 * quad + r, 16); Bq[r] = __shfl(bv, 4 * quad + r, 16); }
        { float pm[4]; f32x4 lt;
#pragma unroll
          for (int r = 0; r < 4; ++r) { const int j = 4 * quad + r; pm[r] = (li >= j) ? accP[r] * __expf(G - Gq[r]) : 0.f; lt[r] = (j > li) ? Bq[r] * __expf(Gq[r] - G) * accK[r] : 0.f; }
          u32x2 w; w.x = cvt_pk_bf16(pm[0], pm[1]); w.y = cvt_pk_bf16(pm[2], pm[3]); *(u32x2*)(rec + HR_HP + lane * 8) = w;
          *(LAS f32x4*)(Lt + li * 20 + 4 * quad) = lt; }
        const float eG = __expf(G);
        if (lane < 16) { tab[lane] = bv * eG; tab[16 + lane] = bv; *(float*)(rec + HR_HT + lane * 4) = eG; *(float*)(rec + HR_HT + 64 + lane * 4) = __expf(Gl - G); if (lane == 0) *(float*)(rec + HR_HT + 128) = __expf(Gl); }
        LDS_WAIT();
        float t[16];
#pragma unroll
        for (int j = 15; j >= 0; --j) {
            float sacc = (li == j) ? 1.f : 0.f;
#pragma unroll
            for (int mq = 0; mq < 4; ++mq) { if (4 * mq + 3 > j) { const f32x4 lv = *(const LAS f32x4*)(Lt + j * 20 + 4 * mq);
#pragma unroll
                for (int r = 0; r < 4; ++r) { const int m = 4 * mq + r; if (m > j) sacc -= t[m] * lv[r]; } } }
            t[j] = sacc;
        }
        float s1[16], s2[16];
#pragma unroll
        for (int mq = 0; mq < 4; ++mq) { const f32x4 x1 = *(const LAS f32x4*)(tab + 4 * mq), x2 = *(const LAS f32x4*)(tab + 16 + 4 * mq);
#pragma unroll
            for (int r = 0; r < 4; ++r) { s1[4 * mq + r] = x1[r]; s2[4 * mq + r] = x2[r]; } }
        bf16x8 T1, T2;
        { float a1[8], a2[8];
#pragma unroll
          for (int e = 0; e < 8; ++e) { a1[e] = quad == 0 ? t[e] * s1[e] : (quad == 1 ? t[8 + e] * s1[8 + e] : 0.f); a2[e] = quad == 0 ? t[e] * s2[e] : (quad == 1 ? t[8 + e] * s2[8 + e] : 0.f); }
          u32x4 w1, w2; w1.x = cvt_pk_bf16(a1[0], a1[1]); w1.y = cvt_pk_bf16(a1[2], a1[3]); w1.z = cvt_pk_bf16(a1[4], a1[5]); w1.w = cvt_pk_bf16(a1[6], a1[7]);
          w2.x = cvt_pk_bf16(a2[0], a2[1]); w2.y = cvt_pk_bf16(a2[2], a2[3]); w2.z = cvt_pk_bf16(a2[4], a2[5]); w2.w = cvt_pk_bf16(a2[6], a2[7]);
          T1 = __builtin_bit_cast(bf16x8, w1); T2 = __builtin_bit_cast(bf16x8, w2); }
        const int tr0 = (8 * quad + tq) & 15, tr1 = (8 * quad + 4 + tq) & 15;
#define TRA(img, row, c) ((img) + (row) * 256 + (((2 * (c) + (tp >> 1)) ^ (row)) << 4) + (tp & 1) * 8)
        const f32x4 zero4 = {0.f, 0.f, 0.f, 0.f};
#pragma unroll
        for (int ks = 0; ks < 4; ++ks) {
            const f32x4 w0 = __builtin_amdgcn_mfma_f32_16x16x32_bf16(tr_frag8(TRA(Ki, tr0, 2 * ks), TRA(Ki, tr1, 2 * ks)), T1, zero4, 0, 0, 0);
            const f32x4 w1 = __builtin_amdgcn_mfma_f32_16x16x32_bf16(tr_frag8(TRA(Ki, tr0, 2 * ks + 1), TRA(Ki, tr1, 2 * ks + 1)), T1, zero4, 0, 0, 0);
            u32x4 w; w.x = cvt_pk_bf16(-w0[0], -w0[1]); w.y = cvt_pk_bf16(-w0[2], -w0[3]); w.z = cvt_pk_bf16(-w1[0], -w1[1]); w.w = cvt_pk_bf16(-w1[2], -w1[3]);
            *(u32x4*)(rec + ks * 1024 + lane * 16) = w;
        }
        *(u32x4*)(rec + HR_T2 + lane * 16) = __builtin_bit_cast(u32x4, T2);
        LDS_WAIT();
    }
}

constexpr int GS_K = 6144, GS_Q = GS_K + 4096, GS_V = GS_Q + 4096, GS_SLOT = GS_V + 2048, GS_RING = 8, GS_PD = 7;
static_assert(GS_SLOT * GS_RING <= 131072, "ring below the LDS control words");
__device__ __forceinline__ void phase_gdnseq(const Args& a, int seg, LAS unsigned char* lds) {
    const int wave = wave_id(), lane = threadIdx.x & 63, li = lane & 15, quad = lane >> 4, tq = li >> 2, tp = li & 3;
    unsigned char* ws = a.ws;
    const bf16_t* Q = (const bf16_t*)(ws + WS_QC); const bf16_t* Kc = (const bf16_t*)(ws + WS_SLOTS + 7 * SLOT); const bf16_t* Vc = (const bf16_t*)(ws + WS_SLOTS + 6 * SLOT);
    bf16_t* O = (bf16_t*)(ws + WS_SLOTS + 6 * SLOT); const unsigned char* hbase = ws + WS_SLOTS; float* state = (float*)(ws + WS_STATE);
    constexpr int NST = L / 16;
    for (int un = blockIdx.x; un < NB * NH * 2; un += gridDim.x) {
        const int pr = (un >> 4) * 8 + (un & 7), hf = (un >> 3) & 1, b = pr >> 3, h = pr & 7;
        if (wave >= 4) {
            const int lw = wave - 4;
            auto issue = [&](int c) {
                const int cc = c < NST ? c : NST - 1;
                LAS unsigned char* slot = lds + (c % GS_RING) * GS_SLOT;
                const unsigned char* rec = hbase + ((size_t)(b * NST + cc) * NH + h) * HREC;
                __builtin_amdgcn_global_load_lds((const unsigned*)(rec + lw * 1024 + lane * 16), (LAS unsigned*)(slot + lw * 1024), 16, 0, 0);
                const size_t ro = (size_t)(b * L + cc * 16 + 4 * lw + quad) * D + h * HD + ((li ^ (4 * lw + quad)) & 15) * 8;
                __builtin_amdgcn_global_load_lds((const unsigned*)(Kc + ro), (LAS unsigned*)(slot + GS_K + lw * 1024), 16, 0, 0);
                __builtin_amdgcn_global_load_lds((const unsigned*)(Q + ro), (LAS unsigned*)(slot + GS_Q + lw * 1024), 16, 0, 0);
                if (lw < 2) { const int vrow = 8 * lw + (lane >> 3);
                    __builtin_amdgcn_global_load_lds((const unsigned*)(Vc + (size_t)(b * L + cc * 16 + vrow) * D + h * HD + hf * 64 + (((lane & 7) ^ (vrow & 7)) * 8)), (LAS unsigned*)(slot + GS_V + lw * 1024), 16, 0, 0); }
                else __builtin_amdgcn_global_load_lds((const unsigned*)(rec + 4096 + (lw - 2) * 1024 + lane * 16), (LAS unsigned*)(slot + 4096 + (lw - 2) * 1024), 16, 0, 0);
            };
#pragma unroll 1
            for (int c = 0; c < GS_PD; ++c) issue(c);
            asm volatile("s_waitcnt vmcnt(24)" ::: "memory");
            __builtin_amdgcn_s_barrier();
#pragma unroll 1
            for (int s = 0; s < NST; ++s) {
                issue(s + GS_PD);
                asm volatile("s_waitcnt vmcnt(24)" ::: "memory");
                __builtin_amdgcn_s_barrier();
            }
            asm volatile("s_waitcnt vmcnt(0)" ::: "memory");
        } else {
            const int d = wave;
            float* st = state + ((size_t)(b * NH + h) * 128 + 4 * quad) * 128 + hf * 64 + 16 * d + li;
            f32x4 S[8];
#pragma unroll
            for (int c = 0; c < 8; ++c)
#pragma unroll
                for (int r = 0; r < 4; ++r) S[c][r] = seg > 0 ? st[(16 * c + r) * 128] : 0.f;
            bf16_t* orow = O + (size_t)(b * L + 4 * quad) * D + h * HD + hf * 64 + 16 * d + li;
            __builtin_amdgcn_s_barrier(); asm volatile("" ::: "memory");
#pragma unroll 1
            for (int s = 0; s < NST; ++s) {
                const LAS unsigned char* sb = lds + (s % GS_RING) * GS_SLOT;
                bf16x8 Sb[4];
#pragma unroll
                for (int ks = 0; ks < 4; ++ks) { u32x4 w; w.x = cvt_pk_bf16(S[2 * ks][0], S[2 * ks][1]); w.y = cvt_pk_bf16(S[2 * ks][2], S[2 * ks][3]); w.z = cvt_pk_bf16(S[2 * ks + 1][0], S[2 * ks + 1][1]); w.w = cvt_pk_bf16(S[2 * ks + 1][2], S[2 * ks + 1][3]); Sb[ks] = __builtin_bit_cast(bf16x8, w); }
                const int tr0 = (8 * quad + tq) & 15, tr1 = (8 * quad + 4 + tq) & 15;
#define TRV(row) (sb + GS_V + (row) * 128 + (((2 * d + (tp >> 1)) ^ ((row) & 7)) << 4) + (tp & 1) * 8)
                f32x4 vn = __builtin_amdgcn_mfma_f32_16x16x32_bf16(*(const LAS bf16x8*)(sb + HR_T2 + lane * 16), tr_frag8(TRV(tr0), TRV(tr1)), (f32x4){0.f, 0.f, 0.f, 0.f}, 0, 0, 0);
#pragma unroll
                for (int ks = 0; ks < 4; ++ks) vn = __builtin_amdgcn_mfma_f32_16x16x32_bf16(*(const LAS bf16x8*)(sb + ks * 1024 + lane * 16), Sb[ks], vn, 0, 0, 0);
                f32x4 oa = {0.f, 0.f, 0.f, 0.f};
#pragma unroll
                for (int ks = 0; ks < 4; ++ks) {
                    const u32x2 q0 = *(const LAS u32x2*)(sb + GS_Q + li * 256 + (((4 * ks + (quad >> 1)) ^ li) << 4) + (quad & 1) * 8), q1 = *(const LAS u32x2*)(sb + GS_Q + li * 256 + (((4 * ks + 2 + (quad >> 1)) ^ li) << 4) + (quad & 1) * 8);
                    const u32x4 qw = {q0.x, q0.y, q1.x, q1.y};
                    oa = __builtin_amdgcn_mfma_f32_16x16x32_bf16(__builtin_bit_cast(bf16x8, qw), Sb[ks], oa, 0, 0, 0);
                }
                const LAS float* ht = (const LAS float*)(sb + HR_HT);
                const f32x4 eG4 = *(const LAS f32x4*)(ht + 4 * quad), eD4 = *(const LAS f32x4*)(ht + 16 + 4 * quad); const float eGl = ht[32];
                oa = oa * eG4;
                const u32x2 pw = *(const LAS u32x2*)(sb + HR_HP + lane * 8);
                const u32x4 pa = {pw.x, pw.y, 0u, 0u};
                const u32x4 vb = {cvt_pk_bf16(vn[0], vn[1]), cvt_pk_bf16(vn[2], vn[3]), 0u, 0u};
                oa = __builtin_amdgcn_mfma_f32_16x16x32_bf16(__builtin_bit_cast(bf16x8, pa), __builtin_bit_cast(bf16x8, vb), oa, 0, 0, 0);
#pragma unroll
                for (int r = 0; r < 4; ++r) orow[(size_t)(s * 16 + r) * D] = (bf16_t)(cvt_pk_bf16(oa[r], 0.f) & 0xffffu);
                const f32x4 vs = vn * eD4;
                const u32x4 vsw = {cvt_pk_bf16(vs[0], vs[1]), cvt_pk_bf16(vs[2], vs[3]), 0u, 0u};
                const bf16x8 Vs = __builtin_bit_cast(bf16x8, vsw);
#pragma unroll
                for (int c = 0; c < 8; ++c) {
                    const s16x4 kt = __builtin_amdgcn_ds_read_tr16_b64_v4i16((LAS s16x4*)(sb + GS_K + (4 * quad + tq) * 256 + (((2 * c + (tp >> 1)) ^ (4 * quad + tq)) << 4) + (tp & 1) * 8));
                    const bf16x8 ka = __builtin_shufflevector(kt, kt, 0, 1, 2, 3, 4, 5, 6, 7);
                    S[c] = __builtin_amdgcn_mfma_f32_16x16x32_bf16(ka, Vs, S[c] * eGl, 0, 0, 0);
                }
                asm volatile("s_waitcnt lgkmcnt(0)" ::: "memory"); __builtin_amdgcn_s_barrier(); asm volatile("" ::: "memory");
            }
#pragma unroll
            for (int c = 0; c < 8; ++c)
#pragma unroll
                for (int r = 0; r < 4; ++r) st[(16 * c + r) * 128] = S[c][r];
        }
        __syncthreads();
    }
}

__device__ __forceinline__ void phase_gnorm(const Args& a) {
    const int wave = wave_id(), lane = threadIdx.x & 63;
    unsigned char* ws = a.ws;
    const bf16_t* O = (const bf16_t*)(ws + WS_SLOTS + 6 * SLOT); const bf16_t* Z = (const bf16_t*)(ws + WS_SLOTS + 3 * SLOT); unsigned char* ON = ws + WS_SLOTS + 1 * SLOT;
    const int gw = blockIdx.x * 8 + wave, NGW = gridDim.x * 8;
    float gn[8]; ldf8(a.in[I_GNG] + (lane & 15) * 8, gn);
    for (int it0 = gw; it0 < MS * 2; it0 += 4 * NGW) {
        u32x4 ow[4], zw[4]; size_t off[4];
#pragma unroll
        for (int q = 0; q < 4; ++q) { const int it = it0 + q * NGW; off[q] = (size_t)(it >> 1) * D + (it & 1) * 512 + lane * 8;
            if (it < MS * 2) { ow[q] = *(const u32x4*)(O + off[q]); zw[q] = *(const u32x4*)(Z + off[q]); } }
#pragma unroll
        for (int q = 0; q < 4; ++q) { const int it = it0 + q * NGW; if (it < MS * 2) {
            float ov[8] = {bflo(ow[q].x), bfhi(ow[q].x), bflo(ow[q].y), bfhi(ow[q].y), bflo(ow[q].z), bfhi(ow[q].z), bflo(ow[q].w), bfhi(ow[q].w)};
            float zv[8] = {bflo(zw[q].x), bfhi(zw[q].x), bflo(zw[q].y), bfhi(zw[q].y), bflo(zw[q].z), bfhi(zw[q].z), bflo(zw[q].w), bfhi(zw[q].w)};
            float r[8], ss = 0.f;
#pragma unroll
            for (int i = 0; i < 8; ++i) ss += ov[i] * ov[i];
            ss += __shfl_xor(ss, 1); ss += __shfl_xor(ss, 2); ss += __shfl_xor(ss, 4); ss += __shfl_xor(ss, 8);
            const float rs = 1.0f / sqrtf(ss * (1.0f / HD) + EPS);
#pragma unroll
            for (int i = 0; i < 8; ++i) r[i] = ov[i] * rs * gn[i] * (zv[i] * sigmoidf_(zv[i]));
            st8_fp8(ON + off[q], r); } }
    }
}

__device__ __forceinline__ void phase_router(const Args& a, int seg, LAS unsigned char* lds) {
    const int tid = threadIdx.x, wave = wave_id(), lane = threadIdx.x & 63;
    unsigned char* ws = a.ws;
    const bf16_t* hsrc = (const bf16_t*)a.out; unsigned char* hb = ws + WS_SLOTS + 9 * SLOT; const bf16_t* wrt = (const bf16_t*)(ws + WS_WR);
    float* rs2 = (float*)(ws + WS_RS2); int* tope = (int*)(ws + WS_TOPE); float* topw = (float*)(ws + WS_TOPW); int* hist = (int*)(ws + WS_HIST); int* rowtok = (int*)(ws + WS_ROWTOK);
    LAS int* lhist = (LAS int*)lds; LAS float* lg = (LAS float*)(lds + 1024) + wave * (16 * 33);
    const int tk = lane & 15, quad = lane >> 4;
    for (int i = blockIdx.x * 512 + tid; i < MAXT * 256; i += gridDim.x * 512) rowtok[i] = 0;
    for (int g = blockIdx.x; g < NG; g += gridDim.x) {
        if (tid < 32) lhist[tid] = 0;
        __syncthreads();
        const int r = g * 128 + wave * 16 + tk; const int Rg = grow(seg, r);
        const bf16_t* hr = hsrc + (size_t)Rg * (2 * D) + quad * 8; unsigned char* ho = hb + (size_t)r * D + quad * 8;
        const bf16_t* w0 = wrt + (size_t)tk * D + quad * 8; const bf16_t* w1 = w0 + 16 * D;
        f32x4 acc0 = {0.f, 0.f, 0.f, 0.f}, acc1 = {0.f, 0.f, 0.f, 0.f}; float ss = 0.f;
        u32x4 keep[32];
#pragma unroll
        for (int ks = 0; ks < 32; ++ks) {
            const u32x4 k = *(const u32x4*)(hr + ks * 32); keep[ks] = k;
            const float e0 = bflo(k.x), e1 = bfhi(k.x), e2 = bflo(k.y), e3 = bfhi(k.y), e4 = bflo(k.z), e5 = bfhi(k.z), e6 = bflo(k.w), e7 = bfhi(k.w);
            ss += (e0 * e0 + e1 * e1) + (e2 * e2 + e3 * e3) + (e4 * e4 + e5 * e5) + (e6 * e6 + e7 * e7);
        }
        ss += __shfl_xor(ss, 16); ss += __shfl_xor(ss, 32);
        const float rs = 1.0f / sqrtf(ss * (1.0f / D) + EPS);
        asm volatile("" ::: "memory");
#pragma unroll
        for (int ks = 0; ks < 32; ++ks) {
            u32x4 k = keep[ks]; asm volatile("" : "+v"(k));
            const float e0 = bflo(k.x) * rs, e1 = bfhi(k.x) * rs, e2 = bflo(k.y) * rs, e3 = bfhi(k.y) * rs, e4 = bflo(k.z) * rs, e5 = bfhi(k.z) * rs, e6 = bflo(k.w) * rs, e7 = bfhi(k.w) * rs;
            u32x4 p; p.x = cvt_pk_bf16(e0, e1); p.y = cvt_pk_bf16(e2, e3); p.z = cvt_pk_bf16(e4, e5); p.w = cvt_pk_bf16(e6, e7);
            { u32x2 p8; p8.x = cvt_pk4_fp8(e0, e1, e2, e3); p8.y = cvt_pk4_fp8(e4, e5, e6, e7); *(u32x2*)(ho + ks * 32) = p8; }
            const bf16x8 f0 = *(const bf16x8*)(w0 + ks * 32), f1 = *(const bf16x8*)(w1 + ks * 32);
            acc0 = __builtin_amdgcn_mfma_f32_16x16x32_bf16(f0, __builtin_bit_cast(bf16x8, p), acc0, 0, 0, 0);
            acc1 = __builtin_amdgcn_mfma_f32_16x16x32_bf16(f1, __builtin_bit_cast(bf16x8, p), acc1, 0, 0, 0);
            if ((ks & 3) == 3) asm volatile("" ::: "memory");
        }
#pragma unroll
        for (int j = 0; j < 4; ++j) { lg[tk * 33 + quad * 4 + j] = acc0[j] + a.in[I_BR][quad * 4 + j]; lg[tk * 33 + 16 + quad * 4 + j] = acc1[j] + a.in[I_BR][16 + quad * 4 + j]; }
        LDS_WAIT();
        if (lane < 16) {
            float v0 = -3.0e38f, v1 = -3.0e38f, v2 = -3.0e38f, v3 = -3.0e38f; int i0 = 0, i1 = 0, i2 = 0, i3 = 0;
            for (int e = 0; e < NE; ++e) { const float xv = lg[lane * 33 + e];
                if (xv > v3) { if (xv > v2) { v3 = v2; i3 = i2; if (xv > v1) { v2 = v1; i2 = i1; if (xv > v0) { v1 = v0; i1 = i0; v0 = xv; i0 = e; } else { v1 = xv; i1 = e; } } else { v2 = xv; i2 = e; } } else { v3 = xv; i3 = e; } } }
            const float e1 = expf(v1 - v0), e2 = expf(v2 - v0), e3 = expf(v3 - v0), inv = 1.0f / (1.0f + e1 + e2 + e3);
            *(i32x4*)(tope + (size_t)r * 4) = (i32x4){i0, i1, i2, i3}; *(f32x4*)(topw + (size_t)r * 4) = (f32x4){inv, e1 * inv, e2 * inv, e3 * inv};
            rs2[r] = rs;
            atomicAdd((int*)&lhist[i0], 1); atomicAdd((int*)&lhist[i1], 1); atomicAdd((int*)&lhist[i2], 1); atomicAdd((int*)&lhist[i3], 1);
        }
        __syncthreads();
        if (tid < 32) hist[g * 32 + tid] = lhist[tid];
        __syncthreads();
    }
}

__device__ __forceinline__ void phase_positions(const Args& a, LAS unsigned char* lds) {
    const int tid = threadIdx.x, wave = wave_id(), lane = threadIdx.x & 63;
    unsigned char* ws = a.ws;
    const int* hist = (const int*)(ws + WS_HIST); const int* tope = (const int*)(ws + WS_TOPE); int* dest = (int*)(ws + WS_DEST); int* rowtok = (int*)(ws + WS_ROWTOK); int* meta = (int*)(ws + WS_META);
    LAS int* tot = (LAS int*)lds; LAS int* pre = tot + 32; LAS int* pstart = pre + 32; LAS int* wcnt = pstart + 32;
    for (int g = blockIdx.x; g < NG; g += gridDim.x) {
        if (tid < 64) tot[tid] = 0;
        __syncthreads();
        { const int e = tid & 31, part = tid >> 5; int t_ = 0, p_ = 0;
          for (int gg = part; gg < NG; gg += 16) { const int hv = hist[gg * 32 + e]; t_ += hv; if (gg < g) p_ += hv; }
          atomicAdd((int*)&tot[e], t_); atomicAdd((int*)&pre[e], p_); }
        __syncthreads();
        if (tid == 0) { int run = 0; for (int e = 0; e < NE; ++e) { pstart[e] = run; run += ((tot[e] + 255) >> 8) << 8; } if (g == 0) meta[0] = run >> 8; }
        __syncthreads();
        if (g == 0 && tid < 32) { const int t0 = pstart[tid] >> 8, t1 = t0 + ((tot[tid] + 255) >> 8); for (int t = t0; t < t1; ++t) meta[64 + t] = tid; }
        const int tokr = g * 128 + (tid >> 2), kx = tid & 3; const int my_e = tope[(size_t)tokr * 4 + kx];
        int rk = 0;
#pragma nounroll
        for (int e = 0; e < NE; ++e) { const unsigned long long mask = __ballot(my_e == e); if (my_e == e) rk = __popcll(mask & ((1ull << lane) - 1ull)); if (lane == 0) wcnt[wave * 32 + e] = __popcll(mask); }
        __syncthreads();
        int off = 0;
        for (int w = 0; w < wave; ++w) off += wcnt[w * 32 + my_e];
        const int dst = pstart[my_e] + pre[my_e] + off + rk;
        dest[(size_t)tokr * 4 + kx] = dst; rowtok[dst] = tokr;
        __syncthreads();
    }
}

__device__ __forceinline__ void phase_combine(const Args& a, int seg) {
    const int wave = wave_id(), lane = threadIdx.x & 63;
    unsigned char* ws = a.ws;
    const unsigned char* Y = ws + WS_Y; const int* dest = (const int*)(ws + WS_DEST); const float* topw = (const float*)(ws + WS_TOPW);
    const int gw = blockIdx.x * 8 + wave, NGW = gridDim.x * 8;
    f32x4 gf[4];
#pragma unroll
    for (int j = 0; j < 4; ++j) gf[j] = *(const f32x4*)(a.in[I_NFIN] + lane * 4 + 256 * j);
    for (int r = gw; r < MS; r += NGW) {
        float* hp = a.out + (size_t)grow(seg, r) * D + lane * 4; const bf16_t* hb16 = (const bf16_t*)(a.out + (size_t)grow(seg, r) * D) + lane * 4;
        const i32x4 dd = *(const i32x4*)(dest + (size_t)r * 4); const f32x4 ww = *(const f32x4*)(topw + (size_t)r * 4);
        f32x4 v[4];
#pragma unroll
        for (int j = 0; j < 4; ++j) { const u32x2 hw = *(const u32x2*)(hb16 + 256 * j); v[j] = (f32x4){bflo(hw.x), bfhi(hw.x), bflo(hw.y), bfhi(hw.y)}; }
#pragma unroll
        for (int k = 0; k < 4; ++k) { const unsigned char* yr = Y + (size_t)dd[k] * D + lane * 4; const float wk = ww[k];
#pragma unroll
            for (int j = 0; j < 4; ++j) { const unsigned p = *(const unsigned*)(yr + 256 * j);
                const f32x2 lo = __builtin_amdgcn_cvt_pk_f32_fp8((int)p, false), hi = __builtin_amdgcn_cvt_pk_f32_fp8((int)p, true);
                v[j][0] += wk * lo.x; v[j][1] += wk * lo.y; v[j][2] += wk * hi.x; v[j][3] += wk * hi.y; } }
        float ss = 0.f;
#pragma unroll
        for (int j = 0; j < 4; ++j) ss += (v[j][0] * v[j][0] + v[j][1] * v[j][1]) + (v[j][2] * v[j][2] + v[j][3] * v[j][3]);
#pragma unroll
        for (int o = 1; o < 64; o <<= 1) ss += __shfl_xor(ss, o);
        const float rs = 1.0f / sqrtf(ss * (1.0f / D) + EPS);
#pragma unroll
        for (int j = 0; j < 4; ++j) *(f32x4*)(hp + 256 * j) = v[j] * rs * gf[j];
    }
}

constexpr int NPH = 14;
__device__ __forceinline__ bool in_range(int k) { const Args a = load_args(); return a.ph_lo <= k && k < a.ph_hi; }
__device__ __forceinline__ bool seg_on(int sgi) { const Args a = load_args(); return a.seg_lo <= sgi && sgi < a.seg_hi; }
__device__ __forceinline__ bool do_pro() { const Args a = load_args(); return a.do_pro != 0; }
__global__ void __launch_bounds__(512, 2) hyb_fwd(Args args_unused) {
    extern __shared__ __attribute__((aligned(16))) unsigned char lds_raw[];
    LAS unsigned char* lds = (LAS unsigned char*)lds_raw;
    const int tid = threadIdx.x;
    volatile LAS unsigned* MISC = (volatile LAS unsigned*)(lds + MISC_OFF);
    if (tid < 32) MISC[tid] = 0u;
    __syncthreads();
    if (!MK_MULTI) { const Args a0 = load_args(); (void)xcd_barrier_post((unsigned*)(a0.ws + WS_CTL) + CW_BAR, MISC + 8); }
#define GRID_BAR() do { if (!MK_MULTI) { XcdBarrier b_; { const Args ab_ = load_args(); b_.bar = (unsigned*)(ab_.ws + WS_CTL) + CW_BAR; } b_.x = xb_xcc_id(); b_.st = (volatile LAS unsigned*)(lds + MISC_OFF) + 8; xcd_barrier(b_); } } while (0)
#define IN(k) ((ONLY < 0 || ONLY == (k)) && in_range(k))
#define SEG_ON(s) seg_on(s)
#define DO_PRO do_pro()
    if ((ONLY < 0 || ONLY == 99) && DO_PRO) REPS(20) { const Args args = load_args(); phase_prep(args, lds); GRID_BAR(); }

#define SEG_BODY(SEGC) if (SEG_ON(SEGC)) { constexpr int seg = (SEGC); \
        if (IN(0)) REPS(0) { const Args args = load_args(); unsigned char* ws = args.ws; (void)ws; phase_cast(args, seg); GRID_BAR(); } \
        if (IN(1)) REPS(1) { const Args args = load_args(); unsigned char* ws = args.ws; (void)ws; \
            pg8::SchedDense S; S.init(MS / 256, NIN / 256, gridDim.x, blockIdx.x, 4); S.A = (const char*)(ws + WS_SLOTS + 9 * SLOT); S.B = (const char*)(ws + WS_WIN); \
            pg8::EpiInProj E{(bf16_t*)(ws + WS_SLOTS), (const float*)(ws + WS_RS1), args.out, seg}; \
            pg8::gemm_phase<pg8::EpiInProj, pg8::SchedDense, PG8_ALIGN, PG8_SP2>(lds, S, E); \
            GRID_BAR(); \
        } \
        if (IN(2)) REPS(2) { const Args args = load_args(); unsigned char* ws = args.ws; (void)ws; phase_sconv(args, seg); }   \
        if (IN(3)) REPS(3) { const Args args = load_args(); unsigned char* ws = args.ws; (void)ws; phase_qkvconv(args, seg); GRID_BAR(); } \
        if (IN(4)) REPS(4) { const Args args = load_args(); unsigned char* ws = args.ws; (void)ws; phase_gdnprep(args, lds); GRID_BAR(); } \
        if (IN(5)) REPS(5) { const Args args = load_args(); unsigned char* ws = args.ws; (void)ws; phase_gdnseq(args, seg, lds); GRID_BAR(); } \
        if (IN(6)) REPS(6) { const Args args = load_args(); unsigned char* ws = args.ws; (void)ws; phase_gnorm(args); GRID_BAR(); } \
        if (IN(7)) REPS(7) { const Args args = load_args(); unsigned char* ws = args.ws; (void)ws; \
            { pg8::SchedMerge S; S.init(MS / 256, 4, gridDim.x, blockIdx.x); S.A0 = (const char*)(ws + WS_SLOTS + 1 * SLOT); S.B0 = (const char*)(ws + WS_WOG); S.A1 = (const char*)(ws + WS_SLOTS + 10 * SLOT); S.B1 = (const char*)(ws + WS_WOS); \
              pg8::EpiMerge E{(bf16_t*)(ws + WS_SLOTS + 2 * SLOT), (const bf16_t*)args.out, (const bf16_t*)(ws + WS_SLOTS + 8 * SLOT), seg}; \
              pg8::gemm_phase<pg8::EpiMerge, pg8::SchedMerge, PG8_ALIGN, PG8_SP2>(lds, S, E); } \
            GRID_BAR(); \
        } \
        if (IN(8)) REPS(8) { const Args args = load_args(); unsigned char* ws = args.ws; (void)ws; \
            pg8::SchedDense S; S.init(MS / 256, 4, gridDim.x, blockIdx.x); S.A = (const char*)(ws + WS_SLOTS + 2 * SLOT); S.B = (const char*)(ws + WS_WMX); \
            pg8::EpiMix E{(const bf16_t*)(ws + WS_SLOTS + 9 * SLOT), (const float*)(ws + WS_RS1), args.out, seg}; \
            pg8::gemm_phase<pg8::EpiMix, pg8::SchedDense, PG8_ALIGN, PG8_SP2>(lds, S, E); \
            GRID_BAR(); \
        } \
        if (IN(9)) REPS(9) { const Args args = load_args(); unsigned char* ws = args.ws; (void)ws; phase_router(args, seg, lds); GRID_BAR(); } \
        if (IN(10)) REPS(10) { const Args args = load_args(); unsigned char* ws = args.ws; (void)ws; phase_positions(args, lds); GRID_BAR(); } \
        if (IN(11)) REPS(11) { const Args args = load_args(); unsigned char* ws = args.ws; (void)ws; \
            const int* meta = (const int*)(ws + WS_META); const int ntl = meta[0]; LAS int* tl = (LAS int*)(lds + TILE_E_OFF); \
            for (int i = threadIdx.x; i < ntl; i += 512) tl[i] = meta[64 + i]; \
            __syncthreads(); \
            pg8::SchedMoe1 S; S.init(ntl, 8, gridDim.x, blockIdx.x, 4); S.A = (const char*)(ws + WS_SLOTS + 9 * SLOT); S.B = (const char*)(ws + WS_WGU); S.rowtok = (const int*)(ws + WS_ROWTOK); S.tile_e = tl; \
            pg8::EpiMoe1 E{ws + WS_HID, tl, (const bf16_t*)(ws + WS_BGU16)}; \
            pg8::gemm_phase<pg8::EpiMoe1, pg8::SchedMoe1, PG8_ALIGN, PG8_SP2>(lds, S, E); \
            GRID_BAR(); \
        } \
        if (IN(12)) REPS(12) { const Args args = load_args(); unsigned char* ws = args.ws; (void)ws; \
            const int* meta = (const int*)(ws + WS_META); const int ntl = meta[0]; LAS int* tl = (LAS int*)(lds + TILE_E_OFF); \
            for (int i = threadIdx.x; i < ntl; i += 512) tl[i] = meta[64 + i]; \
            __syncthreads(); \
            pg8::SchedMoe2 S; S.init(ntl, 4, gridDim.x, blockIdx.x, 4); S.A = (const char*)(ws + WS_HID); S.B = (const char*)(ws + WS_WDN); S.tile_e = tl; \
            pg8::EpiMoe2 E{ws + WS_Y, tl, (const bf16_t*)(ws + WS_BDN16)}; \
            pg8::gemm_phase<pg8::EpiMoe2, pg8::SchedMoe2, PG8_ALIGN, PG8_SP2>(lds, S, E); \
            GRID_BAR(); \
        } \
        if (IN(13)) REPS(13) { const Args args = load_args(); unsigned char* ws = args.ws; (void)ws; phase_combine(args, seg); } \
    }
    SEG_BODY(0)
    SEG_BODY(1)
    static_assert(NSEG == 2, "one SEG_BODY per segment");
#undef SEG_BODY
#undef IN
#undef GRID_BAR
}

extern "C" void kernel_launch(void* const* d_in, const int* in_sizes, int n_in, void* d_out, int out_size, void* d_ws, size_t ws_size, hipStream_t stream) {
    static int grid = 0;
    if (grid == 0) {
        if (n_in != 19 || out_size != NB * SEQ * D || ws_size < WS_END) { fprintf(stderr, "kernel_launch: unexpected shapes / workspace (%d inputs, out %d, ws %zu < %zu)\n", n_in, out_size, ws_size, (size_t)WS_END); grid = -1; return; }
        int dev = 0, cus = 0;
        if (hipGetDevice(&dev) != hipSuccess || hipDeviceGetAttribute(&cus, hipDeviceAttributeMultiprocessorCount, dev) != hipSuccess) { grid = -1; return; }
        if (hipFuncSetAttribute((const void*)hyb_fwd, hipFuncAttributeMaxDynamicSharedMemorySize, LDS_BYTES) != hipSuccess) { fprintf(stderr, "kernel_launch: hipFuncSetAttribute failed\n"); grid = -1; return; }
        int per_cu = 0;
        if (hipOccupancyMaxActiveBlocksPerMultiprocessor(&per_cu, (const void*)hyb_fwd, 512, LDS_BYTES) != hipSuccess || per_cu < 1) fprintf(stderr, "kernel_launch: occupancy query reports %d\n", per_cu);
        (void)hipGetLastError();
        grid = cus;
    }
    if (grid < 0) return;
    (void)in_sizes;
    hipMemsetAsync((char*)d_ws + WS_CTL, 0, CTL_BYTES, stream);
    Args a{};
    for (int i = 0; i < 19; ++i) a.in[i] = (const float*)d_in[i];
    a.out = (float*)d_out; a.ws = (unsigned char*)d_ws;
#if MK_MULTI
    a.do_pro = 1; a.seg_lo = 0; a.seg_hi = 0; a.ph_lo = 0; a.ph_hi = 0;
    hipLaunchKernelGGL(hyb_fwd, dim3(grid), dim3(512), LDS_BYTES, stream, a);
    for (int s = 0; s < NSEG; ++s)
        for (int p = 0; p < NPH; ++p) { a.do_pro = 0; a.seg_lo = s; a.seg_hi = s + 1; a.ph_lo = p; a.ph_hi = p + 1; hipLaunchKernelGGL(hyb_fwd, dim3(grid), dim3(512), LDS_BYTES, stream, a); }
#else
    a.do_pro = 1; a.seg_lo = 0; a.seg_hi = NSEG; a.ph_lo = 0; a.ph_hi = NPH;
    hipLaunchKernelGGL(hyb_fwd, dim3(grid), dim3(512), LDS_BYTES, stream, a);
#endif
}
```

```cpp
#include <hip/hip_runtime.h>
#include <cstdio>
#include <cstdint>

#ifndef ONLY
#define ONLY -1
#endif
#ifndef PROBE_MASK
#define PROBE_MASK 0
#endif
#define REPS(k) for (int rep_ = 0; rep_ < (((PROBE_MASK >> (k)) & 1) ? 2 : 1); ++rep_)
#ifndef MK_MULTI
#define MK_MULTI 0
#endif

#define LAS __attribute__((address_space(3)))
typedef unsigned short bf16_t;
typedef short bf16x8 __attribute__((ext_vector_type(8)));
typedef float f32x4 __attribute__((ext_vector_type(4)));
typedef float f32x2 __attribute__((ext_vector_type(2)));
typedef unsigned u32x4 __attribute__((ext_vector_type(4)));
typedef unsigned u32x2 __attribute__((ext_vector_type(2)));
typedef int i32x4 __attribute__((ext_vector_type(4)));

constexpr int D = 1024, NB = 16, SEQ = 4096, NH = 8, HD = 128, NE = 32;
constexpr int NSEG = 2, L = SEQ / NSEG, LLOG = 11, MS = NB * L;
static_assert((1 << LLOG) == L, "LLOG");
constexpr int DIN = 9232, NIN = 9216;
constexpr int MAXT = (4 * MS + NE * 255) / 256;
static_assert(MAXT * 4 <= 147456 - (131072 + 1024), "tile table fits the LDS tail");
constexpr int NG = MS / 128;
constexpr float EPS = 1e-6f;

constexpr size_t MiB = (size_t)1 << 20;
constexpr size_t WS_CTL = 0, CTL_BYTES = 1 * MiB;
constexpr size_t WS_WIN = 1 * MiB;
constexpr size_t WS_WAB = 19 * MiB;
constexpr size_t WS_WR = 19 * MiB + 65536;
constexpr size_t WS_BGU16 = 19 * MiB + 131072;
constexpr size_t WS_BDN16 = 19 * MiB + 131072 + 131072;
constexpr size_t WS_WOG = 20 * MiB, WS_WOS = 22 * MiB, WS_WMX = 24 * MiB;
constexpr size_t WS_WGU = 26 * MiB;
constexpr size_t WS_WDN = 154 * MiB;
constexpr size_t WS_STATE = 218 * MiB;
constexpr size_t WS_MISC = 226 * MiB;
constexpr size_t WS_RS1 = WS_MISC;
constexpr size_t WS_RS2 = WS_RS1 + (size_t)MS * 4;
constexpr size_t WS_GB = WS_RS2 + (size_t)MS * 4;
constexpr size_t WS_TOPE = WS_GB + (size_t)MS * 64;
constexpr size_t WS_TOPW = WS_TOPE + (size_t)MS * 16;
constexpr size_t WS_DEST = WS_TOPW + (size_t)MS * 16;
constexpr size_t WS_HIST = WS_DEST + (size_t)MS * 16;
constexpr size_t WS_ROWTOK = WS_HIST + (size_t)NG * 128;
constexpr size_t WS_HALOQ = WS_ROWTOK + (size_t)MAXT * 1024;
constexpr size_t WS_HALOS = WS_HALOQ + (size_t)2 * 16 * 3 * 3072 * 2;
constexpr size_t WS_META = WS_HALOS + (size_t)2 * 16 * 2 * 1024 * 2;
constexpr size_t WS_MISC_END = WS_META + 4096 + (size_t)MAXT * 4;
constexpr size_t WS_SLOTS = 234 * MiB;
static_assert(WS_MISC_END <= WS_SLOTS, "misc region");
constexpr size_t SLOT = (size_t)MS * D * 2;
constexpr int NSLOT = 11;
constexpr size_t WS_QC = WS_SLOTS + NSLOT * SLOT;
constexpr size_t WS_END = WS_QC + SLOT;
constexpr size_t HID_BYTES = (size_t)MAXT * 256 * 2048;
constexpr size_t WS_HID = WS_SLOTS, WS_Y = WS_SLOTS + ((HID_BYTES + MiB - 1) / MiB) * MiB;
static_assert(WS_Y + HID_BYTES <= WS_SLOTS + 9 * SLOT, "MoE buffers overlay the dead projection slots");
constexpr int CW_BAR = 4096;

constexpr int LDS_BYTES = 147456, MISC_OFF = 131072 + 320, TILE_E_OFF = 131072 + 1024;

typedef __bf16 bf16v2_t __attribute__((ext_vector_type(2)));
__device__ __forceinline__ unsigned cvt_pk_bf16(float lo, float hi) { const f32x2 v = {lo, hi}; return __builtin_bit_cast(unsigned, __builtin_convertvector(v, bf16v2_t)); }
__device__ __forceinline__ float bflo(unsigned w) { return __uint_as_float(w << 16); }
__device__ __forceinline__ float bfhi(unsigned w) { return __uint_as_float(w & 0xffff0000u); }
__device__ __forceinline__ float sigmoidf_(float x) { return __builtin_amdgcn_rcpf(1.0f + __expf(-x)); }
__device__ __forceinline__ int grow(int seg, int r) { return ((r >> LLOG) << 12) + seg * L + (r & (L - 1)); }
__device__ __forceinline__ float sat8(float v) { return __builtin_amdgcn_fmed3f(v, -448.0f, 448.0f); }
__device__ __forceinline__ unsigned cvt_pk4_fp8(float a, float b, float c, float d) { int w = __builtin_amdgcn_cvt_pk_fp8_f32(a, b, 0, false); w = __builtin_amdgcn_cvt_pk_fp8_f32(c, d, w, true); return (unsigned)w; }
#define LDS_WAIT() asm volatile("s_waitcnt lgkmcnt(0)" ::: "memory")
__device__ __forceinline__ int wave_id() { int t = (int)threadIdx.x; asm volatile("" : "+v"(t)); return __builtin_amdgcn_readfirstlane(t >> 6); }

#define XB_TMO      128
#define XB_XCNT(j)  (256  + 64 * (j))
#define XB_XSUB(j)  (1280 + 64 * (j))
#define XB_XGEN(j)  (2304 + 64 * (j))
#define XB_TOP      3328
#define XB_TOPGEN   3392
#define XCD_BAR_WORDS 3456
#define XB_SPIN_CAP (1u << 20)
__device__ __forceinline__ unsigned xb_ld(unsigned* p)              { return __hip_atomic_load(p, __ATOMIC_RELAXED, __HIP_MEMORY_SCOPE_AGENT); }
__device__ __forceinline__ unsigned xb_add(unsigned* p, unsigned v) { return __hip_atomic_fetch_add(p, v, __ATOMIC_RELAXED, __HIP_MEMORY_SCOPE_AGENT); }
__device__ __forceinline__ unsigned xb_xcc_id() { return (unsigned)__builtin_amdgcn_s_getreg((3 << 11) | 20) & 0xFu; }
#define XB_SPIN(cond, bar) do { unsigned _sp = 0; while (cond) { __builtin_amdgcn_s_sleep(1); \
    if ((++_sp & 255u) == 0u) { if (xb_ld(&(bar)[XB_TMO])) break; if (_sp > XB_SPIN_CAP) { atomicAdd(&(bar)[XB_TMO], 1u); break; } } } } while (0)
struct XcdBarrier { unsigned* bar; unsigned x; volatile LAS unsigned* st; };
__device__ __forceinline__ XcdBarrier xcd_barrier_post(unsigned* bar, volatile LAS unsigned* st) {
    XcdBarrier b; b.bar = bar; b.x = xb_xcc_id(); b.st = st;
    if (threadIdx.x == 0) (void)xb_add(&bar[XB_XCNT(b.x)], 1u);
    return b;
}
__device__ __forceinline__ void xcd_barrier_complete(unsigned* bar, unsigned x, unsigned& nloc, unsigned& nx) {
    const unsigned G = gridDim.x * gridDim.y * gridDim.z;
    unsigned sum, cnt, mine, sp = 0u;
    for (;;) {
        sum = 0u; cnt = 0u; mine = 0u;
#pragma unroll
        for (unsigned j = 0; j < 16; ++j) { const unsigned c = xb_ld(&bar[XB_XCNT(j)]); sum += c; cnt += (c > 0u) ? 1u : 0u; mine = (j == x) ? c : mine; }
        if (sum == G) break;
        __builtin_amdgcn_s_sleep(1);
        if ((++sp & 255u) == 0u) { if (xb_ld(&bar[XB_TMO])) break; if (sp > XB_SPIN_CAP) { atomicAdd(&bar[XB_TMO], 1u); break; } }
    }
    nloc = mine > 0u ? mine : 1u; nx = cnt > 0u ? cnt : 1u;
}
__device__ __forceinline__ void xcd_barrier(const XcdBarrier& b) {
    asm volatile("s_waitcnt vmcnt(0)" ::: "memory");
    __syncthreads();
    if (threadIdx.x == 0) {
        unsigned* bar = b.bar;
        __builtin_amdgcn_s_waitcnt(0);
        unsigned nloc = b.st[0], nx = b.st[1];
        if (nloc == 0u) { xcd_barrier_complete(bar, b.x, nloc, nx); b.st[0] = nloc; b.st[1] = nx; }
        const unsigned old = xb_add(&bar[XB_XSUB(b.x)], 1u);
        const unsigned gen = old / nloc;
        if (old + 1u == (gen + 1u) * nloc) {
            __builtin_amdgcn_fence(__ATOMIC_RELEASE, "agent");
            asm volatile("s_waitcnt vmcnt(0)" ::: "memory");
            const unsigned og = xb_add(&bar[XB_TOP], 1u);
            const unsigned tg = og / nx;
            if (og + 1u == (tg + 1u) * nx) xb_add(&bar[XB_TOPGEN], 1u);
            else XB_SPIN(xb_ld(&bar[XB_TOPGEN]) == tg, bar);
            __builtin_amdgcn_fence(__ATOMIC_ACQUIRE, "agent");
            xb_add(&bar[XB_XGEN(b.x)], 1u);
            asm volatile("s_waitcnt vmcnt(0)" ::: "memory");
        } else {
            XB_SPIN(xb_ld(&bar[XB_XGEN(b.x)]) == gen, bar);
            __builtin_amdgcn_fence(__ATOMIC_ACQUIRE, "agent");
            asm volatile("s_waitcnt vmcnt(0)" ::: "memory");
        }
    }
    __syncthreads();
}

namespace pg8 {
constexpr int BM = 256, BK = 64, HALF = 128, HTB = HALF * BK * 2, NXCD = 8, WGM = 8, K = 1024;
__device__ __forceinline__ int lds_byte(int r, int c) { const int st = (r >> 4) * 2 + (c >> 5), rr = r & 15, cc = c & 31, ob = rr * 64 + cc * 2; return st * 1024 + (ob ^ (((ob >> 9) & 1) << 5)); }
__device__ __forceinline__ void stage_rc(int b, int& R, int& C) { const int st = b / 1024, sb = b % 1024, swz = sb ^ (((sb >> 9) & 1) << 5); R = (st >> 1) * 16 + swz / 64; C = (st & 1) * 32 + (swz % 64) / 2; }
__device__ __forceinline__ int perm32(int rho) { const int n = rho >> 4, i = rho & 15; return 8 * (i >> 2) + 4 * n + (i & 3); }
struct Unit { int pm, pn, part; };
typedef int i32x8 __attribute__((ext_vector_type(8)));
typedef int i32x4v __attribute__((ext_vector_type(4)));
__device__ __forceinline__ i32x8 cat8(bf16x8 a, bf16x8 b) { return __builtin_shufflevector(__builtin_bit_cast(i32x4v, a), __builtin_bit_cast(i32x4v, b), 0, 1, 2, 3, 4, 5, 6, 7); }
struct Order {
    int nM, nN, nwg, G, c, wgm, sh; unsigned mnig;
    __device__ __forceinline__ void init(int nM_, int nN_, int G_, int c_, int wgm_ = 8) { nM = nM_; nN = nN_; nwg = nM * nN; G = G_; c = c_; wgm = wgm_; sh = wgm_ == 8 ? 3 : 2; mnig = 0xFFFFFFFFu / (unsigned)(wgm_ * nN_) + 1u; }
    __device__ __forceinline__ bool next(int i, Unit& u) const {
        const long Lx = (long)i * G + c; if (Lx >= nwg) return false;
        unsigned wgid = (unsigned)Lx; { const unsigned q = (unsigned)nwg / NXCD, r = (unsigned)nwg % NXCD, xcd = wgid % NXCD, off = wgid / NXCD; wgid = (xcd < r ? xcd * (q + 1) : r * (q + 1) + (xcd - r) * q) + off; }
        const int nig = wgm * nN, gid = (int)__umulhi(wgid, mnig), rem = (int)wgid - gid * nig, fm = gid * wgm, gsz = (nM - fm) < wgm ? (nM - fm) : wgm;
        if (gsz == wgm) { u.pm = fm + (rem & (wgm - 1)); u.pn = rem >> sh; } else { u.pm = fm + rem % gsz; u.pn = rem / gsz; }
        u.part = 0; return true;
    }
};
template <int ROWB_> struct SchedDenseT : Order {
    static constexpr bool GATHER = false; static constexpr int ROWB = ROWB_;
    const char* A; const char* B;
    __device__ __forceinline__ const char* a_tile(const Unit& u) const { return A + (size_t)u.pm * (BM * ROWB); }
    __device__ __forceinline__ const char* b_tile(const Unit& u) const { return B + (size_t)u.pn * (BM * ROWB); }
    __device__ __forceinline__ void a_offs(const Unit&, const int (&R)[2], const int (&C)[2], unsigned (&o)[2][2]) const {
#pragma unroll
        for (int h = 0; h < 2; ++h)
#pragma unroll
            for (int i = 0; i < 2; ++i) o[h][i] = (unsigned)((h * HALF + R[i]) * ROWB + C[i] * 2);
    }
};
typedef SchedDenseT<2048> SchedDense; typedef SchedDenseT<1024> SchedDense8;
struct SchedMoe1 : Order {
    static constexpr bool GATHER = true; static constexpr int ROWB = 1024;
    const char* A; const char* B; const int* rowtok; const LAS int* tile_e;
    __device__ __forceinline__ const char* a_tile(const Unit&) const { return A; }
    __device__ __forceinline__ const char* b_tile(const Unit& u) const { return B + ((size_t)__builtin_amdgcn_readfirstlane(tile_e[u.pm]) * 2048 + (size_t)u.pn * BM) * ROWB; }
    __device__ __forceinline__ void a_offs(const Unit& u, const int (&R)[2], const int (&C)[2], unsigned (&o)[2][2]) const {
#pragma unroll
        for (int h = 0; h < 2; ++h)
#pragma unroll
            for (int i = 0; i < 2; ++i) o[h][i] = (unsigned)(rowtok[u.pm * BM + h * HALF + R[i]] * ROWB + C[i] * 2);
    }
};
struct SchedMoe2 : Order {
    static constexpr bool GATHER = false; static constexpr int ROWB = 1024;
    const char* A; const char* B; const LAS int* tile_e;
    __device__ __forceinline__ const char* a_tile(const Unit& u) const { return A + (size_t)u.pm * (BM * ROWB); }
    __device__ __forceinline__ const char* b_tile(const Unit& u) const { return B + ((size_t)__builtin_amdgcn_readfirstlane(tile_e[u.pm]) * 1024 + (size_t)u.pn * BM) * ROWB; }
    __device__ __forceinline__ void a_offs(const Unit&, const int (&R)[2], const int (&C)[2], unsigned (&o)[2][2]) const {
#pragma unroll
        for (int h = 0; h < 2; ++h)
#pragma unroll
            for (int i = 0; i < 2; ++i) o[h][i] = (unsigned)((h * HALF + R[i]) * ROWB + C[i] * 2);
    }
};

struct BReg { u32x4 b[2]; };
struct TReg { u32x4 x[2][4][2]; float inv[2][4]; };
template <class E, class = void> struct has_tinit { static constexpr bool value = false; };
template <class E> struct has_tinit<E, decltype((void)E::TINIT)> { static constexpr bool value = E::TINIT; };
template <class E, class = void> struct has_binit { static constexpr bool value = false; };
template <class E> struct has_binit<E, decltype((void)E::BINIT)> { static constexpr bool value = E::BINIT; };
template <class E, class = void> struct keeps_acc { static constexpr bool value = false; };
template <class E> struct keeps_acc<E, decltype((void)E::KEEP)> { static constexpr bool value = E::KEEP; };
__device__ __forceinline__ void bias_init(f32x4 (&acc)[2][2][4][2], const BReg& r) {
#pragma unroll
    for (int bj = 0; bj < 2; ++bj) { const u32x4 bw = r.b[bj]; const f32x4 b0 = {bflo(bw.x), bfhi(bw.x), bflo(bw.y), bfhi(bw.y)}, b1 = {bflo(bw.z), bfhi(bw.z), bflo(bw.w), bfhi(bw.w)};
#pragma unroll
        for (int ai = 0; ai < 2; ++ai)
#pragma unroll
            for (int m = 0; m < 4; ++m) { acc[ai][bj][m][0] = b0; acc[ai][bj][m][1] = b1; } }
}
__device__ __forceinline__ void tile_init(f32x4 (&acc)[2][2][4][2], const TReg& t) {
#pragma unroll
    for (int ai = 0; ai < 2; ++ai)
#pragma unroll
        for (int m = 0; m < 4; ++m) { const float iv = __builtin_amdgcn_rcpf(t.inv[ai][m]);
#pragma unroll
            for (int bj = 0; bj < 2; ++bj) { const u32x4 xw = t.x[ai][m][bj];
                acc[ai][bj][m][0] = (f32x4){bflo(xw.x), bfhi(xw.x), bflo(xw.y), bfhi(xw.y)} * iv; acc[ai][bj][m][1] = (f32x4){bflo(xw.z), bfhi(xw.z), bflo(xw.w), bfhi(xw.w)} * iv; } }
}
template <class Epi, class Sched, bool ALIGN_EPI, bool SP2>
__device__ __forceinline__ void gemm_phase(LAS unsigned char* lds, const Sched& S, const Epi& E) {
    const int tid = threadIdx.x, wid = wave_id(), lane = tid & 63, wr = wid >> 2, wc = wid & 3, fr = lane & 15, fq = lane >> 4;
    constexpr int ROWB = Sched::ROWB, nt = ROWB / 128; constexpr bool FP8 = (ROWB == 1024);
    int Rr[2], Cc[2]; unsigned voffB[2];
#pragma unroll
    for (int i = 0; i < 2; ++i) { int R, C; stage_rc(tid * 16 + i * 8192, R, C); Rr[i] = R; Cc[i] = C; const int Rb = Epi::PERM ? ((R & ~31) + perm32(R & 31)) : R; voffB[i] = (unsigned)(Rb * ROWB + C * 2); }
    const size_t kstep = (size_t)(BK * 2);
    const size_t hstep = (size_t)HALF * ROWB;
    const unsigned ldsw = (unsigned)wid * 1024u;
    const int aoff = lds_byte(wr * 64 + fr, fq * 8), boff = lds_byte(wc * 32 + fr, fq * 8);
#define PG8_SA(b, h) (((b) * 2 + (h)) * HTB)
#define PG8_SB(b, h) ((4 + (b) * 2 + (h)) * HTB)
#define PG8_STAGE(bufoff, gbase, voff) do { _Pragma("unroll") for (int _i = 0; _i < 2; ++_i) \
        __builtin_amdgcn_global_load_lds((const unsigned*)((const char*)(gbase) + (voff)[_i]), (LAS unsigned*)(lds + (bufoff) + ldsw + _i * 8192), 16, 0, 0); } while (0)
#define PG8_LDA(dst, b, h) do { _Pragma("unroll") for (int m = 0; m < 4; ++m) { if constexpr (FP8) dst##8[m] = cat8(*(const LAS bf16x8*)(lds + PG8_SA(b, h) + aoff + m * 2048), *(const LAS bf16x8*)(lds + PG8_SA(b, h) + aoff + m * 2048 + 1024)); \
        else { _Pragma("unroll") for (int k = 0; k < 2; ++k) dst[m][k] = *(const LAS bf16x8*)(lds + PG8_SA(b, h) + aoff + m * 2048 + k * 1024); } } } while (0)
#define PG8_LDB(dst, b, h) do { _Pragma("unroll") for (int n = 0; n < 2; ++n) { if constexpr (FP8) dst##8[n] = cat8(*(const LAS bf16x8*)(lds + PG8_SB(b, h) + boff + n * 2048), *(const LAS bf16x8*)(lds + PG8_SB(b, h) + boff + n * 2048 + 1024)); \
        else { _Pragma("unroll") for (int k = 0; k < 2; ++k) dst[n][k] = *(const LAS bf16x8*)(lds + PG8_SB(b, h) + boff + n * 2048 + k * 1024); } } } while (0)
#define PG8_MMA(ai, bj, At, Bt) do { __builtin_amdgcn_s_setprio(1); _Pragma("unroll") for (int m = 0; m < 4; ++m) _Pragma("unroll") for (int n = 0; n < 2; ++n) { \
        if constexpr (FP8) asm volatile("s_nop 1\n\tv_mfma_scale_f32_16x16x128_f8f6f4 %0, %1, %2, %0, %3, %4 op_sel_hi:[0,0,0]" : "+v"(acc[ai][bj][m][n]) : "v"(Bt##8[n]), "v"(At##8[m]), "v"(sclW), "v"(sclX)); \
        else { _Pragma("unroll") for (int k = 0; k < 2; ++k) acc[ai][bj][m][n] = __builtin_amdgcn_mfma_f32_16x16x32_bf16(Bt[n][k], At[m][k], acc[ai][bj][m][n], 0, 0, 0); } } \
        __builtin_amdgcn_s_setprio(0); } while (0)
#define PG8_WAIT_V(n) asm volatile("s_waitcnt vmcnt(" #n ")" ::: "memory")
#define PG8_WAIT_L(n) asm volatile("s_waitcnt lgkmcnt(" #n ")" ::: "memory")
#define PG8_BAR __builtin_amdgcn_s_barrier()
#define PG8_SCHED __builtin_amdgcn_sched_barrier(0)
    Unit cur, nxt; int ui = 0;
    if (!S.next(0, cur)) return;
    f32x4 acc[2][2][4][2];
    constexpr bool BINIT = has_binit<Epi>::value;
    constexpr bool TINIT = has_tinit<Epi>::value;
    if constexpr (BINIT) { BReg br; E.bias_load(cur, wr, wc, fr, fq, br); bias_init(acc, br); }
    else if constexpr (TINIT) { TReg tr; E.tile_load(cur, wr, wc, fr, fq, tr); tile_init(acc, tr); }
    else {
#pragma unroll
    for (int a = 0; a < 2; ++a)
#pragma unroll
        for (int b = 0; b < 2; ++b)
#pragma unroll
            for (int m = 0; m < 4; ++m)
#pragma unroll
                for (int n = 0; n < 2; ++n) acc[a][b][m][n] = (f32x4){0.f, 0.f, 0.f, 0.f};
    }
    int sclW = 0x7A7A7A7A, sclX = 0x7F7F7F7F; asm volatile("" : "+v"(sclW), "+v"(sclX));
    bf16x8 At[4][2], B0[2][2], B1[2][2]; i32x8 At8[4], B08[2], B18[2]; (void)At; (void)B0; (void)B1; (void)At8; (void)B08; (void)B18;
    unsigned oC[2][2], oN[2][2]; typename Epi::Pre pre;
    S.a_offs(cur, Rr, Cc, oC);
    const char* cA = S.a_tile(cur); const char* cB = S.b_tile(cur);
    if constexpr (SP2) {
        PG8_STAGE(PG8_SB(0, 0), cB, voffB); PG8_STAGE(PG8_SB(0, 1), cB + hstep, voffB); PG8_STAGE(PG8_SA(0, 0), cA, oC[0]); PG8_STAGE(PG8_SA(0, 1), cA, oC[1]);
        if (wr == 1) PG8_BAR;
        PG8_WAIT_V(2); PG8_BAR;
        PG8_STAGE(PG8_SB(1, 0), cB + kstep, voffB); PG8_STAGE(PG8_SA(1, 0), cA + kstep, oC[0]); PG8_STAGE(PG8_SB(1, 1), cB + hstep + kstep, voffB);
        PG8_WAIT_V(6); PG8_BAR;
    } else {
        PG8_STAGE(PG8_SB(0, 0), cB, voffB); PG8_STAGE(PG8_SA(0, 0), cA, oC[0]); PG8_STAGE(PG8_SB(0, 1), cB + hstep, voffB); PG8_STAGE(PG8_SA(0, 1), cA, oC[1]);
        if (wr == 1) PG8_BAR;
        PG8_WAIT_V(4); PG8_BAR;
        PG8_STAGE(PG8_SB(1, 0), cB + kstep, voffB); PG8_STAGE(PG8_SA(1, 0), cA + kstep, oC[0]); PG8_STAGE(PG8_SB(1, 1), cB + hstep + kstep, voffB);
        PG8_WAIT_V(6); PG8_BAR;
    }
    for (;;) {
        const bool has_next = S.next(ui + 1, nxt);
        const char* nA = cA; const char* nB = cB;
        if (has_next) { nA = S.a_tile(nxt); nB = S.b_tile(nxt); if constexpr (Sched::GATHER) S.a_offs(nxt, Rr, Cc, oN); }
        else if constexpr (Sched::GATHER) {
#pragma unroll
            for (int h = 0; h < 2; ++h)
#pragma unroll
                for (int i = 0; i < 2; ++i) oN[h][i] = oC[h][i];
        }
#pragma nounroll
        for (int t = 0; t < nt; t += 2) {
            const bool last = (t == nt - 2);
            if (last) E.prefetch(cur, wr, wc, fr, fq, pre);
            const char* a1 = cA + (size_t)(t + 1) * kstep;
            const char* a2 = last ? nA : cA + (size_t)(t + 2) * kstep; const char* b2 = last ? nB : cB + (size_t)(t + 2) * kstep;
            const char* a3 = a2 + kstep; const char* b3 = b2 + kstep;
            unsigned o2[2][2];
#pragma unroll
            for (int h = 0; h < 2; ++h)
#pragma unroll
                for (int i = 0; i < 2; ++i) { if constexpr (Sched::GATHER) o2[h][i] = last ? oN[h][i] : oC[h][i]; else o2[h][i] = oC[h][i]; }
            if constexpr (SP2) {
            PG8_LDB(B0, 0, 0); PG8_LDB(B1, 0, 1); PG8_SCHED; PG8_LDA(At, 0, 0); PG8_STAGE(PG8_SA(1, 1), a1, oC[1]);
            PG8_WAIT_V(8); PG8_WAIT_L(0); PG8_BAR; PG8_MMA(0, 0, At, B0); PG8_MMA(0, 1, At, B1); PG8_BAR; PG8_SCHED;
            PG8_LDA(At, 0, 1); PG8_STAGE(PG8_SB(0, 0), b2, voffB); PG8_STAGE(PG8_SB(0, 1), b2 + hstep, voffB); PG8_STAGE(PG8_SA(0, 0), a2, o2[0]);
            PG8_WAIT_V(8); PG8_WAIT_L(0); PG8_BAR; PG8_MMA(1, 0, At, B0); PG8_MMA(1, 1, At, B1); PG8_BAR; PG8_SCHED;
            PG8_LDB(B0, 1, 0); PG8_LDB(B1, 1, 1); PG8_SCHED; PG8_LDA(At, 1, 0); PG8_STAGE(PG8_SA(0, 1), a2, o2[1]);
            PG8_WAIT_V(8); PG8_WAIT_L(0); PG8_BAR; PG8_MMA(0, 0, At, B0); PG8_MMA(0, 1, At, B1); PG8_BAR; PG8_SCHED;
            PG8_LDA(At, 1, 1); PG8_STAGE(PG8_SB(1, 0), b3, voffB); PG8_STAGE(PG8_SB(1, 1), b3 + hstep, voffB); PG8_STAGE(PG8_SA(1, 0), a3, o2[0]);
            PG8_WAIT_V(8); PG8_WAIT_L(0); PG8_BAR; PG8_MMA(1, 0, At, B0); PG8_MMA(1, 1, At, B1); PG8_BAR; PG8_SCHED;
            } else {
            PG8_LDB(B0, 0, 0); PG8_SCHED; PG8_LDA(At, 0, 0); PG8_STAGE(PG8_SA(1, 1), a1, oC[1]);
            PG8_WAIT_L(8); PG8_BAR; PG8_WAIT_L(0); PG8_MMA(0, 0, At, B0); PG8_BAR; PG8_SCHED;
            PG8_LDB(B1, 0, 1); PG8_STAGE(PG8_SB(0, 0), b2, voffB);
            PG8_BAR; PG8_WAIT_L(0); PG8_MMA(0, 1, At, B1); PG8_BAR;
            PG8_LDA(At, 0, 1); PG8_STAGE(PG8_SA(0, 0), a2, o2[0]);
            PG8_BAR; PG8_WAIT_L(0); PG8_MMA(1, 0, At, B0); PG8_BAR; PG8_SCHED;
            PG8_STAGE(PG8_SB(0, 1), b2 + hstep, voffB);
            PG8_WAIT_V(6); PG8_BAR; PG8_MMA(1, 1, At, B1); PG8_BAR;
            PG8_LDB(B0, 1, 0); PG8_SCHED; PG8_LDA(At, 1, 0); PG8_STAGE(PG8_SA(0, 1), a2, o2[1]);
            PG8_WAIT_L(8); PG8_BAR; PG8_WAIT_L(0); PG8_MMA(0, 0, At, B0); PG8_BAR; PG8_SCHED;
            PG8_LDB(B1, 1, 1); PG8_STAGE(PG8_SB(1, 0), b3, voffB);
            PG8_BAR; PG8_WAIT_L(0); PG8_MMA(0, 1, At, B1); PG8_BAR;
            PG8_LDA(At, 1, 1); PG8_STAGE(PG8_SA(1, 0), a3, o2[0]);
            PG8_BAR; PG8_WAIT_L(0); PG8_MMA(1, 0, At, B0); PG8_BAR; PG8_SCHED;
            PG8_STAGE(PG8_SB(1, 1), b3 + hstep, voffB);
            PG8_WAIT_V(6); PG8_BAR; PG8_MMA(1, 1, At, B1); PG8_BAR;
            }
        }
        if constexpr (ALIGN_EPI) { if (wr == 0) PG8_BAR; }
        BReg br; (void)br;
        if constexpr (BINIT) E.bias_load(has_next ? nxt : cur, wr, wc, fr, fq, br);
        if constexpr (FP8) asm volatile("s_nop 15\n\ts_nop 15" ::: "memory");
        E(acc, cur, wr, wc, fr, fq, pre);
        if (!has_next) break;
        if constexpr (BINIT) bias_init(acc, br);
        else if constexpr (TINIT) { TReg tr; E.tile_load(nxt, wr, wc, fr, fq, tr); tile_init(acc, tr); }
        else if (!(keeps_acc<Epi>::value && cur.part == 0)) {
#pragma unroll
        for (int a = 0; a < 2; ++a)
#pragma unroll
            for (int b = 0; b < 2; ++b)
#pragma unroll
                for (int m = 0; m < 4; ++m)
#pragma unroll
                    for (int n = 0; n < 2; ++n) acc[a][b][m][n] = (f32x4){0.f, 0.f, 0.f, 0.f};
        }
        cur = nxt; cA = nA; cB = nB; ++ui;
        if constexpr (Sched::GATHER) {
#pragma unroll
        for (int h = 0; h < 2; ++h)
#pragma unroll
            for (int i = 0; i < 2; ++i) oC[h][i] = oN[h][i]; }
        if constexpr (ALIGN_EPI) { if (wr == 1) PG8_BAR; }
    }
    PG8_WAIT_V(0);
    if constexpr (!ALIGN_EPI) { if (wr == 0) PG8_BAR; }
    PG8_BAR;
#undef PG8_SA
#undef PG8_SB
#undef PG8_STAGE
#undef PG8_LDA
#undef PG8_LDB
#undef PG8_MMA
#undef PG8_WAIT_V
#undef PG8_WAIT_L
#undef PG8_BAR
#undef PG8_SCHED
}

typedef f32x4 Acc[2][2][4][2];
__device__ __forceinline__ u32x4 widen16(u32x2 xa, u32x2 xb) {
    const auto r0 = __builtin_amdgcn_permlane16_swap(xa.x, xb.x, false, false), r1 = __builtin_amdgcn_permlane16_swap(xa.y, xb.y, false, false);
    return (u32x4){r0[0], r1[0], r0[1], r1[1]};
}
struct NoPre {};
struct EpiInProj {
    typedef NoPre Pre; __device__ __forceinline__ void prefetch(const Unit&, int, int, int, int, Pre&) const {}
    static constexpr bool PERM = true;
    bf16_t* slots; const float* rs1; float* out; int seg;
    __device__ __forceinline__ void operator()(Acc& acc, const Unit& u, int wr, int wc, int fr, int fq, const Pre& pre) const {
        const int pn = u.pn, row0 = u.pm * BM + wr * 64 + fr;
        const bool ptile = (pn >= 16 && pn < 20) || (pn >= 24 && pn < 28), gtile = pn >= 28;
        if (ptile) {
            const int q = pn < 20 ? pn - 16 : pn - 20, col0 = q * HALF + wc * 32 + 8 * fq;
            bf16_t* base = slots + (size_t)4 * ((size_t)MS * D);
#pragma unroll
            for (int ai = 0; ai < 2; ++ai)
#pragma unroll
                for (int m = 0; m < 4; ++m) { const f32x4 v0 = acc[ai][0][m][0] * acc[ai][1][m][0], v1 = acc[ai][0][m][1] * acc[ai][1][m][1];
                    u32x4 w; w.x = cvt_pk_bf16(v0[0], v0[1]); w.y = cvt_pk_bf16(v0[2], v0[3]); w.z = cvt_pk_bf16(v1[0], v1[1]); w.w = cvt_pk_bf16(v1[2], v1[3]);
                    *(u32x4*)(base + (size_t)(row0 + ai * HALF + m * 16) * D + col0) = w; }
        } else if (gtile) {
            const int col0 = (pn - 28) * HALF + wc * 32 + 8 * fq;
            bf16_t* bA = (bf16_t*)out; bf16_t* bB = slots + (size_t)8 * ((size_t)MS * D);
#pragma unroll
            for (int ai = 0; ai < 2; ++ai)
#pragma unroll
                for (int m = 0; m < 4; ++m) { const size_t off = (size_t)(row0 + ai * HALF + m * 16) * D + col0;
                    f32x4 r0, r1, b0, b1;
#pragma unroll
                    for (int j = 0; j < 4; ++j) { b0[j] = sigmoidf_(acc[ai][1][m][0][j]); b1[j] = sigmoidf_(acc[ai][1][m][1][j]);
                        r0[j] = sigmoidf_(acc[ai][0][m][0][j]) * __builtin_amdgcn_rcpf(1e-20f + b0[j]); r1[j] = sigmoidf_(acc[ai][0][m][1][j]) * __builtin_amdgcn_rcpf(1e-20f + b1[j]); }
                    u32x4 w; w.x = cvt_pk_bf16(r0[0], r0[1]); w.y = cvt_pk_bf16(r0[2], r0[3]); w.z = cvt_pk_bf16(r1[0], r1[1]); w.w = cvt_pk_bf16(r1[2], r1[3]);
                    *(u32x4*)(bA + (size_t)grow(seg, row0 + ai * HALF + m * 16) * (2 * D) + col0) = w;
                    w.x = cvt_pk_bf16(b0[0], b0[1]); w.y = cvt_pk_bf16(b0[2], b0[3]); w.z = cvt_pk_bf16(b1[0], b1[1]); w.w = cvt_pk_bf16(b1[2], b1[3]);
                    *(u32x4*)(bB + off) = w; }
        } else {
            const int arr = pn >> 2, col0 = (pn & 3) * BM + wc * 32 + 8 * fq;
            bf16_t* base = slots + (size_t)arr * ((size_t)MS * D);
#pragma unroll
            for (int ai = 0; ai < 2; ++ai)
#pragma unroll
                for (int m = 0; m < 4; ++m) { const int row = row0 + ai * HALF + m * 16; bf16_t* rowp = base + (size_t)row * D + col0;
#pragma unroll
                    for (int bj = 0; bj < 2; ++bj) { const f32x4 v0 = acc[ai][bj][m][0], v1 = acc[ai][bj][m][1];
                        u32x4 w; w.x = cvt_pk_bf16(v0[0], v0[1]); w.y = cvt_pk_bf16(v0[2], v0[3]); w.z = cvt_pk_bf16(v1[0], v1[1]); w.w = cvt_pk_bf16(v1[2], v1[3]);
                        *(u32x4*)(rowp + bj * HALF) = w; } }
        }
    }
};
struct SchedMerge : Order {
    static constexpr bool GATHER = false; static constexpr int ROWB = 1024;
    const char* A0; const char* B0; const char* A1; const char* B1;
    __device__ __forceinline__ bool next(int i, Unit& u) const { const bool ok = Order::next(i >> 1, u); u.part = i & 1; return ok; }
    __device__ __forceinline__ const char* a_tile(const Unit& u) const { return (u.part ? A1 : A0) + (size_t)u.pm * (BM * ROWB); }
    __device__ __forceinline__ const char* b_tile(const Unit& u) const { return (u.part ? B1 : B0) + (size_t)u.pn * (BM * ROWB); }
    __device__ __forceinline__ void a_offs(const Unit&, const int (&R)[2], const int (&C)[2], unsigned (&o)[2][2]) const {
#pragma unroll
        for (int h = 0; h < 2; ++h)
#pragma unroll
            for (int i = 0; i < 2; ++i) o[h][i] = (unsigned)((h * HALF + R[i]) * ROWB + C[i] * 2);
    }
};
struct EpiMerge {
    typedef NoPre Pre; __device__ __forceinline__ void prefetch(const Unit&, int, int, int, int, Pre&) const {}
    static constexpr bool PERM = true, KEEP = true;
    bf16_t* out; const bf16_t* gA; const bf16_t* gB; int seg;
    __device__ __forceinline__ void operator()(Acc& acc, const Unit& u, int wr, int wc, int fr, int fq, const Pre&) const {
        const int col0 = u.pn * BM + wc * 32 + 8 * fq, row0 = u.pm * BM + wr * 64 + fr;
        if (u.part == 0) {
#pragma unroll
            for (int ai = 0; ai < 2; ++ai)
#pragma unroll
                for (int m = 0; m < 4; ++m) { const size_t off = (size_t)grow(seg, row0 + ai * HALF + m * 16) * (2 * D) + col0;
#pragma unroll
                    for (int bj = 0; bj < 2; ++bj) { const u32x4 a = *(const u32x4*)(gA + off + bj * HALF);
                        f32x4& v0 = acc[ai][bj][m][0]; f32x4& v1 = acc[ai][bj][m][1];
                        v0[0] *= bflo(a.x); v0[1] *= bfhi(a.x); v0[2] *= bflo(a.y); v0[3] *= bfhi(a.y); v1[0] *= bflo(a.z); v1[1] *= bfhi(a.z); v1[2] *= bflo(a.w); v1[3] *= bfhi(a.w); }
                    if (m & 1) asm volatile("" ::: "memory"); }
        } else {
#pragma unroll
            for (int ai = 0; ai < 2; ++ai)
#pragma unroll
                for (int m = 0; m < 4; ++m) { const size_t off = (size_t)(row0 + ai * HALF + m * 16) * D + col0;
#pragma unroll
                    for (int bj = 0; bj < 2; ++bj) { const u32x4 g = *(const u32x4*)(gB + off + bj * HALF);
                        f32x4 v0 = acc[ai][bj][m][0], v1 = acc[ai][bj][m][1];
                        v0[0] *= bflo(g.x); v0[1] *= bfhi(g.x); v0[2] *= bflo(g.y); v0[3] *= bfhi(g.y); v1[0] *= bflo(g.z); v1[1] *= bfhi(g.z); v1[2] *= bflo(g.w); v1[3] *= bfhi(g.w);
                        u32x4 w; w.x = cvt_pk_bf16(v0[0], v0[1]); w.y = cvt_pk_bf16(v0[2], v0[3]); w.z = cvt_pk_bf16(v1[0], v1[1]); w.w = cvt_pk_bf16(v1[2], v1[3]);
                        *(u32x4*)(out + off + bj * HALF) = w; }
                    if (m & 1) asm volatile("" ::: "memory"); }
        }
    }
};
struct EpiMix {
    typedef NoPre Pre; __device__ __forceinline__ void prefetch(const Unit&, int, int, int, int, Pre&) const {}
    static constexpr bool PERM = true, TINIT = true;
    const bf16_t* xb; const float* rs1; float* out; int seg;
    __device__ __forceinline__ void tile_load(const Unit& u, int wr, int wc, int fr, int fq, TReg& t) const {
        const int col0 = u.pn * BM + wc * 32 + 8 * fq, row0 = u.pm * BM + wr * 64 + fr;
#pragma unroll
        for (int ai = 0; ai < 2; ++ai)
#pragma unroll
            for (int m = 0; m < 4; ++m) { const int row = row0 + ai * HALF + m * 16; t.inv[ai][m] = rs1[row];
#pragma unroll
                for (int bj = 0; bj < 2; ++bj) t.x[ai][m][bj] = *(const u32x4*)(xb + (size_t)row * D + col0 + bj * HALF); }
    }
    __device__ __forceinline__ void operator()(Acc& acc, const Unit& u, int wr, int wc, int fr, int fq, const Pre& pre) const {
        const int col0 = u.pn * BM + wc * 32 + 8 * fq, row0 = u.pm * BM + wr * 64 + fr;
#pragma unroll
        for (int ai = 0; ai < 2; ++ai)
#pragma unroll
            for (int m = 0; m < 4; ++m) { const int row = row0 + ai * HALF + m * 16; bf16_t* hr = (bf16_t*)out + (size_t)grow(seg, row) * (2 * D) + col0;
#pragma unroll
                for (int bj = 0; bj < 2; ++bj) { const f32x4 v0 = acc[ai][bj][m][0], v1 = acc[ai][bj][m][1];
                    u32x4 w; w.x = cvt_pk_bf16(v0[0], v0[1]); w.y = cvt_pk_bf16(v0[2], v0[3]); w.z = cvt_pk_bf16(v1[0], v1[1]); w.w = cvt_pk_bf16(v1[2], v1[3]);
                    *(u32x4*)(hr + bj * HALF) = w; } }
    }
};
struct EpiMoe1 {
    typedef NoPre Pre; __device__ __forceinline__ void prefetch(const Unit&, int, int, int, int, Pre&) const {}
    static constexpr bool PERM = true, BINIT = true;
    unsigned char* hid; const LAS int* tile_e; const bf16_t* bgu;
    __device__ __forceinline__ void bias_load(const Unit& u, int wr, int wc, int fr, int fq, BReg& r) const {
        const int e = __builtin_amdgcn_readfirstlane(tile_e[u.pm]); const bf16_t* bgp = bgu + (size_t)e * 2048 + u.pn * HALF + wc * 32 + 8 * fq;
        r.b[0] = *(const u32x4*)bgp; r.b[1] = *(const u32x4*)(bgp + 1024);
    }
    __device__ __forceinline__ void operator()(Acc& acc, const Unit& u, int wr, int wc, int fr, int fq, const Pre&) const {
        const int row0 = u.pm * BM + wr * 64 + fr;
#pragma unroll
        for (int ai = 0; ai < 2; ++ai) { u32x2 w[4];
#pragma unroll
            for (int m = 0; m < 4; ++m) {
                const f32x4 g0 = acc[ai][0][m][0], g1 = acc[ai][0][m][1], u0 = acc[ai][1][m][0], u1 = acc[ai][1][m][1];
                f32x4 h0, h1;
#pragma unroll
                for (int j = 0; j < 4; ++j) {
                    const float ga = __builtin_amdgcn_fmed3f(g0[j], -3.0e38f, 7.0f), gb = __builtin_amdgcn_fmed3f(g1[j], -3.0e38f, 7.0f);
                    const float ua = __builtin_amdgcn_fmed3f(u0[j], -7.0f, 7.0f), ub = __builtin_amdgcn_fmed3f(u1[j], -7.0f, 7.0f);
                    h0[j] = __builtin_fmaf(ua, ga, ga) * __builtin_amdgcn_rcpf(1.0f + __builtin_amdgcn_exp2f(ga * -2.45546696f));
                    h1[j] = __builtin_fmaf(ub, gb, gb) * __builtin_amdgcn_rcpf(1.0f + __builtin_amdgcn_exp2f(gb * -2.45546696f)); }
                w[m].x = cvt_pk4_fp8(h0[0], h0[1], h0[2], h0[3]); w[m].y = cvt_pk4_fp8(h1[0], h1[1], h1[2], h1[3]); }
#pragma unroll
            for (int mp = 0; mp < 2; ++mp) *(u32x4*)(hid + (size_t)(row0 + 16 * (fq & 1) + ai * HALF + mp * 32) * D + u.pn * HALF + wc * 32 + 8 * (fq & 2)) = widen16(w[2 * mp], w[2 * mp + 1]); }
    }
};
struct EpiMoe2 {
    typedef NoPre Pre; __device__ __forceinline__ void prefetch(const Unit&, int, int, int, int, Pre&) const {}
    static constexpr bool PERM = true, BINIT = true;
    unsigned char* y; const LAS int* tile_e; const bf16_t* bdn;
    __device__ __forceinline__ void bias_load(const Unit& u, int wr, int wc, int fr, int fq, BReg& r) const {
        const int e = __builtin_amdgcn_readfirstlane(tile_e[u.pm]); const int col0 = u.pn * BM + wc * 32 + 8 * fq;
#pragma unroll
        for (int bj = 0; bj < 2; ++bj) r.b[bj] = *(const u32x4*)(bdn + (size_t)e * D + col0 + bj * HALF);
    }
    __device__ __forceinline__ void operator()(Acc& acc, const Unit& u, int wr, int wc, int fr, int fq, const Pre&) const {
        const int colw = u.pn * BM + wc * 32 + 8 * (fq & 2), row0 = u.pm * BM + wr * 64 + fr + 16 * (fq & 1);
#pragma unroll
        for (int ai = 0; ai < 2; ++ai)
#pragma unroll
            for (int bj = 0; bj < 2; ++bj) { u32x2 w[4];
#pragma unroll
                for (int m = 0; m < 4; ++m) { const f32x4 v0 = acc[ai][bj][m][0], v1 = acc[ai][bj][m][1]; w[m].x = cvt_pk4_fp8(v0[0], v0[1], v0[2], v0[3]); w[m].y = cvt_pk4_fp8(v1[0], v1[1], v1[2], v1[3]); }
#pragma unroll
                for (int mp = 0; mp < 2; ++mp) *(u32x4*)(y + (size_t)(row0 + ai * HALF + mp * 32) * D + colw + bj * HALF) = widen16(w[2 * mp], w[2 * mp + 1]); }
    }
};
}

#ifndef PG8_SP2
#define PG8_SP2 true
#endif
#ifndef PG8_ALIGN
#define PG8_ALIGN true
#endif

struct Args { const float* in[19]; float* out; unsigned char* ws; int do_pro, seg_lo, seg_hi, ph_lo, ph_hi, pad; };
enum { I_X = 0, I_NMG, I_WIN, I_CONVW, I_ALOG, I_DTB, I_GNG, I_WOG, I_SCW, I_WOS, I_WMX, I_NFG, I_WR, I_BR, I_WGU, I_BGU, I_WDN, I_BDN, I_NFIN };

typedef const __attribute__((address_space(4))) Args* KArgsP;
__device__ __forceinline__ Args load_args() {
#if defined(__HIP_DEVICE_COMPILE__)
    KArgsP p = (KArgsP)__builtin_amdgcn_kernarg_segment_ptr(); asm volatile("" : "+s"(p)); return *p;
#else
    return Args{};
#endif
}
__device__ __forceinline__ void tr_item(const float* __restrict__ src, int ld, int c0, const float* __restrict__ scale, bf16_t* dst, int k0, LAS float* scr, int lane) {
#pragma unroll 8
    for (int i = 0; i < 32; ++i) { const int kk = 2 * i + (lane >> 5); float v = src[(size_t)(k0 + kk) * ld + c0 + (lane & 31)]; if (scale) v *= scale[k0 + kk]; scr[kk * 33 + (lane & 31)] = v; }
    LDS_WAIT();
    const int c = lane & 7;
#pragma unroll
    for (int j = 0; j < 4; ++j) { const int n = (lane >> 3) + 8 * j; const LAS float* s = scr + (8 * c) * 33 + n;
        u32x4 o; o.x = cvt_pk_bf16(s[0 * 33], s[1 * 33]); o.y = cvt_pk_bf16(s[2 * 33], s[3 * 33]); o.z = cvt_pk_bf16(s[4 * 33], s[5 * 33]); o.w = cvt_pk_bf16(s[6 * 33], s[7 * 33]);
        *(u32x4*)(dst + (size_t)n * 1024 + k0 + 8 * c) = o; }
    LDS_WAIT();
}
template <bool FP8OUT>
__device__ __forceinline__ void tr_item64(const float* __restrict__ src, int ld, int c0, const float* __restrict__ scale, float mul, unsigned char* dst, int k0, LAS float* scr, int lane) {
    const int nl = (lane & 15) * 4, kl = lane >> 4;
    f32x4 v[8];
#pragma unroll
    for (int i = 0; i < 8; ++i) v[i] = *(const f32x4*)(src + (size_t)(k0 + 4 * i + kl) * ld + c0 + nl);
#pragma unroll
    for (int i = 0; i < 8; ++i) { const int kk = 4 * i + kl; const float sc = scale ? scale[k0 + kk] * mul : mul;
#pragma unroll
        for (int j = 0; j < 4; ++j) scr[kk * 65 + nl + j] = v[i][j] * sc; }
    LDS_WAIT();
#pragma unroll
    for (int t = 0; t < 4; ++t) { const int task = t * 64 + lane, n = task >> 2, c = task & 3; const LAS float* sp = scr + (8 * c) * 65 + n;
        if constexpr (FP8OUT) { u32x2 o; o.x = cvt_pk4_fp8(sp[0], sp[65], sp[130], sp[195]); o.y = cvt_pk4_fp8(sp[260], sp[325], sp[390], sp[455]); *(u32x2*)(dst + (size_t)n * 1024 + k0 + 8 * c) = o; }
        else { u32x4 o; o.x = cvt_pk_bf16(sp[0], sp[65]); o.y = cvt_pk_bf16(sp[130], sp[195]); o.z = cvt_pk_bf16(sp[260], sp[325]); o.w = cvt_pk_bf16(sp[390], sp[455]); *(u32x4*)(dst + (size_t)n * 2048 + (k0 + 8 * c) * 2) = o; } }
    LDS_WAIT();
}
template <int NSUB>
__device__ __forceinline__ void tr_run64_fp8(const float* __restrict__ src, int ld, int c0, const float* __restrict__ scale, float mul, unsigned char* dst, int k0, LAS float* scr, int lane) {
    const int nl = (lane & 15) * 4, kl = lane >> 4;
    const float* p = src + (size_t)(k0 + kl) * ld + c0 + nl;
    f32x4 v[8];
#pragma unroll
    for (int i = 0; i < 8; ++i) v[i] = *(const f32x4*)(p + (size_t)(4 * i) * ld);
#pragma unroll
    for (int sb = 0; sb < NSUB; ++sb) {
        const int kb = k0 + 32 * sb;
#pragma unroll
        for (int i = 0; i < 8; ++i) { const int kk = 4 * i + kl; const float sc = scale ? scale[kb + kk] * mul : mul;
#pragma unroll
            for (int j = 0; j < 4; ++j) scr[kk * 65 + nl + j] = v[i][j] * sc; }
        if (sb + 1 < NSUB) {
#pragma unroll
            for (int i = 0; i < 8; ++i) v[i] = *(const f32x4*)(p + (size_t)(32 * (sb + 1) + 4 * i) * ld); }
        LDS_WAIT();
#pragma unroll
        for (int t = 0; t < 2; ++t) { const int task = t * 64 + lane, n = task >> 1, c = task & 1; const LAS float* sp = scr + (16 * c) * 65 + n;
            u32x4 o; o.x = cvt_pk4_fp8(sp[0], sp[65], sp[130], sp[195]); o.y = cvt_pk4_fp8(sp[260], sp[325], sp[390], sp[455]);
            o.z = cvt_pk4_fp8(sp[520], sp[585], sp[650], sp[715]); o.w = cvt_pk4_fp8(sp[780], sp[845], sp[910], sp[975]);
            *(u32x4*)(dst + (size_t)n * 1024 + kb + 16 * c) = o; }
        LDS_WAIT();
    }
}
__device__ __forceinline__ void phase_prep(const Args& a, LAS unsigned char* lds) {
    const int wave = wave_id(), lane = threadIdx.x & 63;
    LAS float* scr = (LAS float*)(lds + wave * 8448);
    unsigned char* ws = a.ws;
    constexpr int I_IN = 32 * 144, I_SQ = 32 * 16, U_GU = 32 * 8 * 32, U_DN = 32 * 8 * 16, I_AB = 16, I_R = 16;
    constexpr int NIT = I_IN + 3 * I_SQ + I_AB + I_R;
    const int gw = blockIdx.x * 8 + wave, NGW = gridDim.x * 8;
    for (int i = gw * 64 + lane; i < NE * 2048 / 2; i += NGW * 64) ((unsigned*)(ws + WS_BGU16))[i] = cvt_pk_bf16(a.in[I_BGU][2 * i], a.in[I_BGU][2 * i + 1]);
    for (int i = gw * 64 + lane; i < NE * 1024 / 2; i += NGW * 64) ((unsigned*)(ws + WS_BDN16))[i] = cvt_pk_bf16(a.in[I_BDN][2 * i], a.in[I_BDN][2 * i + 1]);
    for (int u = gw; u < U_GU + U_DN; u += NGW) {
        if (u < U_GU) { const int e = u >> 8, kq = (u >> 5) & 7, nb = u & 31, n0 = nb * 64, pn = n0 >> 8, bj = (n0 >> 7) & 1, j0 = n0 & 127, c0 = bj * 1024 + pn * 128 + j0;
            tr_run64_fp8<4>(a.in[I_WGU] + (size_t)e * 1024 * 2048, 2048, c0, a.in[I_NFG], 32.0f, ws + WS_WGU + ((size_t)e * 2048 + n0) * 1024, kq * 128, scr, lane); }
        else { const int r = u - U_GU, e = r >> 7, kq = (r >> 4) & 7, nb = r & 15;
            tr_run64_fp8<4>(a.in[I_WDN] + (size_t)e * 1024 * 1024, 1024, nb * 64, nullptr, 32.0f, ws + WS_WDN + ((size_t)e * 1024 + nb * 64) * 1024, kq * 128, scr, lane); }
    }
    for (int it = gw; it < NIT; it += NGW) {
        int r = it;
        if (r < I_IN) { const int kb = r / 144, nb = r % 144, n0 = nb * 64;
            int lc = n0; { const int pn = n0 >> 8, hf = (n0 >> 7) & 1, j = n0 & 127;
                if ((pn >= 16 && pn < 20) || (pn >= 24 && pn < 28)) lc = (hf ? 6 : 4) * 1024 + (pn < 20 ? pn - 16 : pn - 20) * 128 + j;
                else if (pn >= 28) lc = (hf ? 8 : 7) * 1024 + (pn - 28) * 128 + j; }
            const int c0 = lc < 4096 ? lc : lc + 16;
            tr_item64<false>(a.in[I_WIN], DIN, c0, a.in[I_NMG], 1.0f, ws + WS_WIN + (size_t)n0 * 2048, kb * 32, scr, lane); continue; } r -= I_IN;
        if (r < I_SQ) { const int kb = r >> 4, nb = r & 15; tr_item64<true>(a.in[I_WOG], 1024, nb * 64, nullptr, 32.0f, ws + WS_WOG + (size_t)nb * 64 * 1024, kb * 32, scr, lane); continue; } r -= I_SQ;
        if (r < I_SQ) { const int kb = r >> 4, nb = r & 15; tr_item64<true>(a.in[I_WOS], 1024, nb * 64, nullptr, 32.0f, ws + WS_WOS + (size_t)nb * 64 * 1024, kb * 32, scr, lane); continue; } r -= I_SQ;
        if (r < I_SQ) { const int kb = r >> 4, nb = r & 15; tr_item64<false>(a.in[I_WMX], 1024, nb * 64, nullptr, 1.0f, ws + WS_WMX + (size_t)nb * 64 * 2048, kb * 32, scr, lane); continue; } r -= I_SQ;
        if (r < I_AB) { tr_item(a.in[I_WIN], DIN, 4096, a.in[I_NMG], (bf16_t*)(ws + WS_WAB), r * 64, scr, lane); continue; } r -= I_AB;
        tr_item(a.in[I_WR], 32, 0, a.in[I_NFG], (bf16_t*)(ws + WS_WR), r * 64, scr, lane);
    }
}

__device__ __forceinline__ void phase_cast(const Args& a, int seg) {
    const int wave = wave_id(), lane = threadIdx.x & 63;
    unsigned char* ws = a.ws;
    const float* x = a.in[I_X]; bf16_t* xb = (bf16_t*)(ws + WS_SLOTS + 9 * SLOT); const bf16_t* wab = (const bf16_t*)(ws + WS_WAB);
    float* rs1 = (float*)(ws + WS_RS1); float* gb = (float*)(ws + WS_GB);
    const int gw = blockIdx.x * 8 + wave, NGW = gridDim.x * 8, tk = lane & 15, quad = lane >> 4;
    for (int grp = gw; grp < MS / 16; grp += NGW) {
        const int r = grp * 16 + tk; const int Rg = grow(seg, r);
        const float* xr = x + (size_t)Rg * D + quad * 8; bf16_t* xo = xb + (size_t)r * D + quad * 8; const bf16_t* wr_ = wab + (size_t)tk * D + quad * 8;
        f32x4 acc = {0.f, 0.f, 0.f, 0.f}; float ss = 0.f;
        u32x4 keep[32];
#pragma unroll
        for (int ks = 0; ks < 32; ++ks) {
            const f32x4 v0 = *(const f32x4*)(xr + ks * 32), v1 = *(const f32x4*)(xr + ks * 32 + 4);
            ss += (v0[0] * v0[0] + v0[1] * v0[1]) + (v0[2] * v0[2] + v0[3] * v0[3]) + (v1[0] * v1[0] + v1[1] * v1[1]) + (v1[2] * v1[2] + v1[3] * v1[3]);
            keep[ks].x = cvt_pk_bf16(v0[0], v0[1]); keep[ks].y = cvt_pk_bf16(v0[2], v0[3]); keep[ks].z = cvt_pk_bf16(v1[0], v1[1]); keep[ks].w = cvt_pk_bf16(v1[2], v1[3]);
        }
        ss += __shfl_xor(ss, 16); ss += __shfl_xor(ss, 32);
        const float rs = 1.0f / sqrtf(ss * (1.0f / D) + EPS);
#pragma unroll
        for (int ks = 0; ks < 32; ++ks) {
            const u32x4 k = keep[ks];
            u32x4 p; p.x = cvt_pk_bf16(bflo(k.x) * rs, bfhi(k.x) * rs); p.y = cvt_pk_bf16(bflo(k.y) * rs, bfhi(k.y) * rs); p.z = cvt_pk_bf16(bflo(k.z) * rs, bfhi(k.z) * rs); p.w = cvt_pk_bf16(bflo(k.w) * rs, bfhi(k.w) * rs);
            *(u32x4*)(xo + ks * 32) = p;
            const bf16x8 wf = *(const bf16x8*)(wr_ + ks * 32);
            acc = __builtin_amdgcn_mfma_f32_16x16x32_bf16(wf, __builtin_bit_cast(bf16x8, p), acc, 0, 0, 0);
        }
        f32x4 o;
#pragma unroll
        for (int j = 0; j < 4; ++j) {
            const int n = quad * 4 + j; const float v = acc[j];
            if (quad < 2) { const float t = v + a.in[I_DTB][n]; const float sp = t > 20.f ? t : log1pf(expf(t)); o[j] = -expf(a.in[I_ALOG][n]) * sp; }
            else o[j] = 1.0f / (1.0f + expf(-v));
        }
        *(f32x4*)(gb + (size_t)r * 16 + quad * 4) = o;
        if (quad == 0) rs1[r] = rs;
    }
}

__device__ __forceinline__ void ld8(const bf16_t* p, float (&v)[8]) { const u32x4 w = *(const u32x4*)p; v[0] = bflo(w.x); v[1] = bfhi(w.x); v[2] = bflo(w.y); v[3] = bfhi(w.y); v[4] = bflo(w.z); v[5] = bfhi(w.z); v[6] = bflo(w.w); v[7] = bfhi(w.w); }
__device__ __forceinline__ void st8(bf16_t* p, const float (&v)[8]) { u32x4 w; w.x = cvt_pk_bf16(v[0], v[1]); w.y = cvt_pk_bf16(v[2], v[3]); w.z = cvt_pk_bf16(v[4], v[5]); w.w = cvt_pk_bf16(v[6], v[7]); *(u32x4*)p = w; }
__device__ __forceinline__ void st8_fp8(unsigned char* p, const float (&v)[8]) { u32x2 w; w.x = cvt_pk4_fp8(sat8(v[0]), sat8(v[1]), sat8(v[2]), sat8(v[3])); w.y = cvt_pk4_fp8(sat8(v[4]), sat8(v[5]), sat8(v[6]), sat8(v[7])); *(u32x2*)p = w; }
__device__ __forceinline__ void ldf8(const float* p, float (&v)[8]) { const f32x4 a = *(const f32x4*)p, b = *(const f32x4*)(p + 4); v[0] = a[0]; v[1] = a[1]; v[2] = a[2]; v[3] = a[3]; v[4] = b[0]; v[5] = b[1]; v[6] = b[2]; v[7] = b[3]; }
__device__ __forceinline__ void up8(const u32x4 w, float (&v)[8]) { v[0] = bflo(w.x); v[1] = bfhi(w.x); v[2] = bflo(w.y); v[3] = bfhi(w.y); v[4] = bflo(w.z); v[5] = bfhi(w.z); v[6] = bflo(w.w); v[7] = bfhi(w.w); }
constexpr int TBK = 32;
__device__ __forceinline__ void phase_sconv(const Args& a, int seg) {
    const int wave = wave_id(), lane = threadIdx.x & 63;
    unsigned char* ws = a.ws;
    const bf16_t* PS = (const bf16_t*)(ws + WS_SLOTS + 4 * SLOT); const bf16_t* Bg = (const bf16_t*)(ws + WS_SLOTS + 5 * SLOT);
    unsigned char* U = ws + WS_SLOTS + 10 * SLOT; bf16_t* halo = (bf16_t*)(ws + WS_HALOS);
    const int gw = blockIdx.x * 8 + wave, NGW = gridDim.x * 8;
    constexpr int NTB = L / TBK, NU = NB * NTB * 2;
    for (int un = gw; un < NU; un += NGW) {
        const int sl = un & 1, tb = (un >> 1) % NTB, b = (un >> 1) / NTB, ch = sl * 512 + lane * 8, tl0 = tb * TBK;
        float w0[8], w1[8], w2[8]; ldf8(a.in[I_SCW] + ch, w0); ldf8(a.in[I_SCW] + 1024 + ch, w1); ldf8(a.in[I_SCW] + 2048 + ch, w2);
        float p2[8], p1[8];
        if (tl0 > 0) { const size_t o2 = (size_t)(b * L + tl0 - 2) * D + ch; ld8(PS + o2, p2); ld8(PS + o2 + D, p1); }
        else if (seg > 0) { const bf16_t* hp = halo + ((size_t)(((seg - 1) & 1) * 16 + b) * 2) * 1024 + ch; ld8(hp, p2); ld8(hp + 1024, p1); }
        else {
#pragma unroll
            for (int i = 0; i < 8; ++i) { p2[i] = 0.f; p1[i] = 0.f; } }
#pragma unroll 1
        for (int t0 = 0; t0 < TBK; t0 += 4) {
            u32x4 pw[4], bw[4];
#pragma unroll
            for (int q = 0; q < 4; ++q) { const size_t o = (size_t)(b * L + tl0 + t0 + q) * D + ch; pw[q] = *(const u32x4*)(PS + o); bw[q] = *(const u32x4*)(Bg + o); }
#pragma unroll
            for (int q = 0; q < 4; ++q) { const size_t o = (size_t)(b * L + tl0 + t0 + q) * D + ch; float pa[8], ba[8], r[8]; up8(pw[q], pa); up8(bw[q], ba);
#pragma unroll
                for (int i = 0; i < 8; ++i) { const float p = pa[i]; r[i] = ba[i] * (w0[i] * p2[i] + w1[i] * p1[i] + w2[i] * p); p2[i] = p1[i]; p1[i] = p; }
                st8_fp8(U + o, r); }
        }
        if (tl0 + TBK == L) { bf16_t* hp = halo + ((size_t)((seg & 1) * 16 + b) * 2) * 1024 + ch; st8(hp, p2); st8(hp + 1024, p1); }
    }
}

__device__ __forceinline__ void phase_qkvconv(const Args& a, int seg) {
    const int wave = wave_id(), lane = threadIdx.x & 63;
    unsigned char* ws = a.ws;
    bf16_t* halo = (bf16_t*)(ws + WS_HALOQ);
    const int gw = blockIdx.x * 8 + wave, NGW = gridDim.x * 8;
    constexpr int NTB = L / TBK, NU = NB * NTB * 6;
    for (int un = gw; un < NU; un += NGW) {
        const int sl = un % 6, tb = (un / 6) % NTB, b = (un / 6) / NTB, arr = sl >> 1, ch = (sl & 1) * 512 + lane * 8, tl0 = tb * TBK;
        const bf16_t* src = (const bf16_t*)(ws + WS_SLOTS + (size_t)arr * SLOT); bf16_t* dst = arr == 0 ? (bf16_t*)(ws + WS_QC) : (bf16_t*)(ws + WS_SLOTS + (size_t)(arr == 1 ? 7 : 6) * SLOT);
        const float* cw = a.in[I_CONVW] + arr * 1024 + ch;
        float w0[8], w1[8], w2[8], w3[8]; ldf8(cw, w0); ldf8(cw + 3072, w1); ldf8(cw + 2 * 3072, w2); ldf8(cw + 3 * 3072, w3);
        float h3[8], h2[8], h1[8];
        if (tl0 > 0) { const size_t o3 = (size_t)(b * L + tl0 - 3) * D + ch; ld8(src + o3, h3); ld8(src + o3 + D, h2); ld8(src + o3 + 2 * D, h1); }
        else if (seg > 0) { const bf16_t* hp = halo + ((size_t)(((seg - 1) & 1) * 16 + b) * 3) * 3072 + arr * 1024 + ch; ld8(hp, h3); ld8(hp + 3072, h2); ld8(hp + 2 * 3072, h1); }
        else {
#pragma unroll
            for (int i = 0; i < 8; ++i) { h3[i] = 0.f; h2[i] = 0.f; h1[i] = 0.f; } }
#pragma unroll 1
        for (int t0 = 0; t0 < TBK; t0 += 8) {
            u32x4 cwv[8];
#pragma unroll
            for (int q = 0; q < 8; ++q) cwv[q] = *(const u32x4*)(src + (size_t)(b * L + tl0 + t0 + q) * D + ch);
#pragma unroll
            for (int q = 0; q < 8; ++q) { const size_t o = (size_t)(b * L + tl0 + t0 + q) * D + ch; float c[8], r[8]; up8(cwv[q], c);
                float ss = 0.f;
#pragma unroll
                for (int i = 0; i < 8; ++i) { const float y = w0[i] * h3[i] + w1[i] * h2[i] + w2[i] * h1[i] + w3[i] * c[i]; const float sv = y * sigmoidf_(y); r[i] = sv; ss += sv * sv; h3[i] = h2[i]; h2[i] = h1[i]; h1[i] = c[i]; }
                if (arr < 2) {
                    ss += __shfl_xor(ss, 1); ss += __shfl_xor(ss, 2); ss += __shfl_xor(ss, 4); ss += __shfl_xor(ss, 8);
                    float sc = 1.0f / sqrtf(ss + EPS); if (arr == 0) sc *= 0.08838834764831845f;
#pragma unroll
                    for (int i = 0; i < 8; ++i) r[i] *= sc;
                }
                st8(dst + o, r); }
        }
        if (tl0 + TBK == L) { bf16_t* hp = halo + ((size_t)((seg & 1) * 16 + b) * 3) * 3072 + arr * 1024 + ch; st8(hp, h3); st8(hp + 3072, h2); st8(hp + 2 * 3072, h1); }
    }
}

typedef short s16x4 __attribute__((ext_vector_type(4)));
constexpr int HREC = 5888, HR_T2 = 4096, HR_HP = 5120, HR_HT = 5632;
constexpr int NCH = MS / 16;
static_assert((size_t)NCH * NH * HREC <= 3 * SLOT, "hand-over records overlay the dead raw q|k|v slots");
__device__ __forceinline__ bf16x8 tr_frag8(const LAS unsigned char* p0, const LAS unsigned char* p1) {
    const s16x4 a = __builtin_amdgcn_ds_read_tr16_b64_v4i16((LAS s16x4*)p0), b = __builtin_amdgcn_ds_read_tr16_b64_v4i16((LAS s16x4*)p1);
    return __builtin_shufflevector(a, b, 0, 1, 2, 3, 4, 5, 6, 7);
}
__device__ __forceinline__ void phase_gdnprep(const Args& a, LAS unsigned char* lds) {
    const int wave = wave_id(), lane = threadIdx.x & 63, li = lane & 15, quad = lane >> 4, tq = li >> 2, tp = li & 3;
    unsigned char* ws = a.ws;
    const bf16_t* Q = (const bf16_t*)(ws + WS_QC); const bf16_t* Kc = (const bf16_t*)(ws + WS_SLOTS + 7 * SLOT);
    const float* gb = (const float*)(ws + WS_GB); unsigned char* hbase = ws + WS_SLOTS;
    LAS unsigned char* wl = lds + wave * 10240;
    LAS unsigned char* Ki = wl; LAS float* Lt = (LAS float*)(wl + 8192); LAS float* tab = (LAS float*)(wl + 8192 + 1280);
    const int gw = blockIdx.x * 8 + wave, NGW = gridDim.x * 8;
    for (int task = gw; task < NCH * NH; task += NGW) {
        const int ci = task >> 3, h = task & 7, r0 = ci * 16;
        const float gv = gb[(size_t)(r0 + li) * 16 + h], bv = gb[(size_t)(r0 + li) * 16 + 8 + h];
        float G = gv;
#pragma unroll
        for (int o = 1; o < 16; o <<= 1) { const float t = __shfl_up(G, o, 16); if (li >= o) G += t; }
        const float Gl = __shfl(G, 15, 16);
        const size_t rowoff = (size_t)(r0 + li) * D + h * HD + quad * 8;
        bf16x8 kf[4], qf[4];
#pragma unroll
        for (int ks = 0; ks < 4; ++ks) { kf[ks] = *(const bf16x8*)(Kc + rowoff + ks * 32); qf[ks] = *(const bf16x8*)(Q + rowoff + ks * 32); }
#pragma unroll
        for (int ks = 0; ks < 4; ++ks) *(LAS bf16x8*)(Ki + li * 256 + (((4 * ks + quad) ^ li) << 4)) = kf[ks];
        f32x4 accK = {0.f, 0.f, 0.f, 0.f}, accP = {0.f, 0.f, 0.f, 0.f};
#pragma unroll
        for (int ks = 0; ks < 4; ++ks) { accK = __builtin_amdgcn_mfma_f32_16x16x32_bf16(kf[ks], kf[ks], accK, 0, 0, 0); accP = __builtin_amdgcn_mfma_f32_16x16x32_bf16(kf[ks], qf[ks], accP, 0, 0, 0); }
        unsigned char* rec = hbase + (size_t)task * HREC;
        float Gq[4], Bq[4];
#pragma unroll
        for (int r = 0; r < 4; ++r) { Gq[r] = __shfl(G, 4 * quad + r, 16); Bq[r] = __shfl(bv, 4 * quad + r, 16); }
        { float pm[4]; f32x4 lt;
#pragma unroll
          for (int r = 0; r < 4; ++r) { const int j = 4 * quad + r; pm[r] = (li >= j) ? accP[r] * __expf(G - Gq[r]) : 0.f; lt[r] = (j > li) ? Bq[r] * __expf(Gq[r] - G) * accK[r] : 0.f; }
          u32x2 w; w.x = cvt_pk_bf16(pm[0], pm[1]); w.y = cvt_pk_bf16(pm[2], pm[3]); *(u32x2*)(rec + HR_HP + lane * 8) = w;
          *(LAS f32x4*)(Lt + li * 20 + 4 * quad) = lt; }
        const float eG = __expf(G);
        if (lane < 16) { tab[lane] = bv * eG; tab[16 + lane] = bv; *(float*)(rec + HR_HT + lane * 4) = eG; *(float*)(rec + HR_HT + 64 + lane * 4) = __expf(Gl - G); if (lane == 0) *(float*)(rec + HR_HT + 128) = __expf(Gl); }
        LDS_WAIT();
        float t[16];
#pragma unroll
        for (int j = 15; j >= 0; --j) {
            float sacc = (li == j) ? 1.f : 0.f;
#pragma unroll
            for (int mq = 0; mq < 4; ++mq) { if (4 * mq + 3 > j) { const f32x4 lv = *(const LAS f32x4*)(Lt + j * 20 + 4 * mq);
#pragma unroll
                for (int r = 0; r < 4; ++r) { const int m = 4 * mq + r; if (m > j) sacc -= t[m] * lv[r]; } } }
            t[j] = sacc;
        }
        float s1[16], s2[16];
#pragma unroll
        for (int mq = 0; mq < 4; ++mq) { const f32x4 x1 = *(const LAS f32x4*)(tab + 4 * mq), x2 = *(const LAS f32x4*)(tab + 16 + 4 * mq);
#pragma unroll
            for (int r = 0; r < 4; ++r) { s1[4 * mq + r] = x1[r]; s2[4 * mq + r] = x2[r]; } }
        bf16x8 T1, T2;
        { float a1[8], a2[8];
#pragma unroll
          for (int e = 0; e < 8; ++e) { a1[e] = quad == 0 ? t[e] * s1[e] : (quad == 1 ? t[8 + e] * s1[8 + e] : 0.f); a2[e] = quad == 0 ? t[e] * s2[e] : (quad == 1 ? t[8 + e] * s2[8 + e] : 0.f); }
          u32x4 w1, w2; w1.x = cvt_pk_bf16(a1[0], a1[1]); w1.y = cvt_pk_bf16(a1[2], a1[3]); w1.z = cvt_pk_bf16(a1[4], a1[5]); w1.w = cvt_pk_bf16(a1[6], a1[7]);
          w2.x = cvt_pk_bf16(a2[0], a2[1]); w2.y = cvt_pk_bf16(a2[2], a2[3]); w2.z = cvt_pk_bf16(a2[4], a2[5]); w2.w = cvt_pk_bf16(a2[6], a2[7]);
          T1 = __builtin_bit_cast(bf16x8, w1); T2 = __builtin_bit_cast(bf16x8, w2); }
        const int tr0 = (8 * quad + tq) & 15, tr1 = (8 * quad + 4 + tq) & 15;
#define TRA(img, row, c) ((img) + (row) * 256 + (((2 * (c) + (tp >> 1)) ^ (row)) << 4) + (tp & 1) * 8)
        const f32x4 zero4 = {0.f, 0.f, 0.f, 0.f};
#pragma unroll
        for (int ks = 0; ks < 4; ++ks) {
            const f32x4 w0 = __builtin_amdgcn_mfma_f32_16x16x32_bf16(tr_frag8(TRA(Ki, tr0, 2 * ks), TRA(Ki, tr1, 2 * ks)), T1, zero4, 0, 0, 0);
            const f32x4 w1 = __builtin_amdgcn_mfma_f32_16x16x32_bf16(tr_frag8(TRA(Ki, tr0, 2 * ks + 1), TRA(Ki, tr1, 2 * ks + 1)), T1, zero4, 0, 0, 0);
            u32x4 w; w.x = cvt_pk_bf16(-w0[0], -w0[1]); w.y = cvt_pk_bf16(-w0[2], -w0[3]); w.z = cvt_pk_bf16(-w1[0], -w1[1]); w.w = cvt_pk_bf16(-w1[2], -w1[3]);
            *(u32x4*)(rec + ks * 1024 + lane * 16) = w;
        }
        *(u32x4*)(rec + HR_T2 + lane * 16) = __builtin_bit_cast(u32x4, T2);
        LDS_WAIT();
    }
}

constexpr int GS_K = 6144, GS_Q = GS_K + 4096, GS_V = GS_Q + 4096, GS_SLOT = GS_V + 2048, GS_RING = 8, GS_PD = 7;
static_assert(GS_SLOT * GS_RING <= 131072, "ring below the LDS control words");
__device__ __forceinline__ void phase_gdnseq(const Args& a, int seg, LAS unsigned char* lds) {
    const int wave = wave_id(), lane = threadIdx.x & 63, li = lane & 15, quad = lane >> 4, tq = li >> 2, tp = li & 3;
    unsigned char* ws = a.ws;
    const bf16_t* Q = (const bf16_t*)(ws + WS_QC); const bf16_t* Kc = (const bf16_t*)(ws + WS_SLOTS + 7 * SLOT); const bf16_t* Vc = (const bf16_t*)(ws + WS_SLOTS + 6 * SLOT);
    bf16_t* O = (bf16_t*)(ws + WS_SLOTS + 6 * SLOT); const unsigned char* hbase = ws + WS_SLOTS; float* state = (float*)(ws + WS_STATE);
    constexpr int NST = L / 16;
    for (int un = blockIdx.x; un < NB * NH * 2; un += gridDim.x) {
        const int pr = (un >> 4) * 8 + (un & 7), hf = (un >> 3) & 1, b = pr >> 3, h = pr & 7;
        if (wave >= 4) {
            const int lw = wave - 4;
            auto issue = [&](int c) {
                const int cc = c < NST ? c : NST - 1;
                LAS unsigned char* slot = lds + (c % GS_RING) * GS_SLOT;
                const unsigned char* rec = hbase + ((size_t)(b * NST + cc) * NH + h) * HREC;
                __builtin_amdgcn_global_load_lds((const unsigned*)(rec + lw * 1024 + lane * 16), (LAS unsigned*)(slot + lw * 1024), 16, 0, 0);
                const size_t ro = (size_t)(b * L + cc * 16 + 4 * lw + quad) * D + h * HD + ((li ^ (4 * lw + quad)) & 15) * 8;
                __builtin_amdgcn_global_load_lds((const unsigned*)(Kc + ro), (LAS unsigned*)(slot + GS_K + lw * 1024), 16, 0, 0);
                __builtin_amdgcn_global_load_lds((const unsigned*)(Q + ro), (LAS unsigned*)(slot + GS_Q + lw * 1024), 16, 0, 0);
                if (lw < 2) { const int vrow = 8 * lw + (lane >> 3);
                    __builtin_amdgcn_global_load_lds((const unsigned*)(Vc + (size_t)(b * L + cc * 16 + vrow) * D + h * HD + hf * 64 + (((lane & 7) ^ (vrow & 7)) * 8)), (LAS unsigned*)(slot + GS_V + lw * 1024), 16, 0, 0); }
                else __builtin_amdgcn_global_load_lds((const unsigned*)(rec + 4096 + (lw - 2) * 1024 + lane * 16), (LAS unsigned*)(slot + 4096 + (lw - 2) * 1024), 16, 0, 0);
            };
#pragma unroll 1
            for (int c = 0; c < GS_PD; ++c) issue(c);
            asm volatile("s_waitcnt vmcnt(24)" ::: "memory");
            __builtin_amdgcn_s_barrier();
#pragma unroll 1
            for (int s = 0; s < NST; ++s) {
                issue(s + GS_PD);
                asm volatile("s_waitcnt vmcnt(24)" ::: "memory");
                __builtin_amdgcn_s_barrier();
            }
            asm volatile("s_waitcnt vmcnt(0)" ::: "memory");
        } else {
            const int d = wave;
            float* st = state + ((size_t)(b * NH + h) * 128 + 4 * quad) * 128 + hf * 64 + 16 * d + li;
            f32x4 S[8];
#pragma unroll
            for (int c = 0; c < 8; ++c)
#pragma unroll
                for (int r = 0; r < 4; ++r) S[c][r] = seg > 0 ? st[(16 * c + r) * 128] : 0.f;
            bf16_t* orow = O + (size_t)(b * L + 4 * quad) * D + h * HD + hf * 64 + 16 * d + li;
            __builtin_amdgcn_s_barrier(); asm volatile("" ::: "memory");
#pragma unroll 1
            for (int s = 0; s < NST; ++s) {
                const LAS unsigned char* sb = lds + (s % GS_RING) * GS_SLOT;
                bf16x8 Sb[4];
#pragma unroll
                for (int ks = 0; ks < 4; ++ks) { u32x4 w; w.x = cvt_pk_bf16(S[2 * ks][0], S[2 * ks][1]); w.y = cvt_pk_bf16(S[2 * ks][2], S[2 * ks][3]); w.z = cvt_pk_bf16(S[2 * ks + 1][0], S[2 * ks + 1][1]); w.w = cvt_pk_bf16(S[2 * ks + 1][2], S[2 * ks + 1][3]); Sb[ks] = __builtin_bit_cast(bf16x8, w); }
                const int tr0 = (8 * quad + tq) & 15, tr1 = (8 * quad + 4 + tq) & 15;
#define TRV(row) (sb + GS_V + (row) * 128 + (((2 * d + (tp >> 1)) ^ ((row) & 7)) << 4) + (tp & 1) * 8)
                f32x4 vn = __builtin_amdgcn_mfma_f32_16x16x32_bf16(*(const LAS bf16x8*)(sb + HR_T2 + lane * 16), tr_frag8(TRV(tr0), TRV(tr1)), (f32x4){0.f, 0.f, 0.f, 0.f}, 0, 0, 0);
#pragma unroll
                for (int ks = 0; ks < 4; ++ks) vn = __builtin_amdgcn_mfma_f32_16x16x32_bf16(*(const LAS bf16x8*)(sb + ks * 1024 + lane * 16), Sb[ks], vn, 0, 0, 0);
                f32x4 oa = {0.f, 0.f, 0.f, 0.f};
#pragma unroll
                for (int ks = 0; ks < 4; ++ks) {
                    const u32x2 q0 = *(const LAS u32x2*)(sb + GS_Q + li * 256 + (((4 * ks + (quad >> 1)) ^ li) << 4) + (quad & 1) * 8), q1 = *(const LAS u32x2*)(sb + GS_Q + li * 256 + (((4 * ks + 2 + (quad >> 1)) ^ li) << 4) + (quad & 1) * 8);
                    const u32x4 qw = {q0.x, q0.y, q1.x, q1.y};
                    oa = __builtin_amdgcn_mfma_f32_16x16x32_bf16(__builtin_bit_cast(bf16x8, qw), Sb[ks], oa, 0, 0, 0);
                }
                const LAS float* ht = (const LAS float*)(sb + HR_HT);
                const f32x4 eG4 = *(const LAS f32x4*)(ht + 4 * quad), eD4 = *(const LAS f32x4*)(ht + 16 + 4 * quad); const float eGl = ht[32];
                oa = oa * eG4;
                const u32x2 pw = *(const LAS u32x2*)(sb + HR_HP + lane * 8);
                const u32x4 pa = {pw.x, pw.y, 0u, 0u};
                const u32x4 vb = {cvt_pk_bf16(vn[0], vn[1]), cvt_pk_bf16(vn[2], vn[3]), 0u, 0u};
                oa = __builtin_amdgcn_mfma_f32_16x16x32_bf16(__builtin_bit_cast(bf16x8, pa), __builtin_bit_cast(bf16x8, vb), oa, 0, 0, 0);
#pragma unroll
                for (int r = 0; r < 4; ++r) orow[(size_t)(s * 16 + r) * D] = (bf16_t)(cvt_pk_bf16(oa[r], 0.f) & 0xffffu);
                const f32x4 vs = vn * eD4;
                const u32x4 vsw = {cvt_pk_bf16(vs[0], vs[1]), cvt_pk_bf16(vs[2], vs[3]), 0u, 0u};
                const bf16x8 Vs = __builtin_bit_cast(bf16x8, vsw);
#pragma unroll
                for (int c = 0; c < 8; ++c) {
                    const s16x4 kt = __builtin_amdgcn_ds_read_tr16_b64_v4i16((LAS s16x4*)(sb + GS_K + (4 * quad + tq) * 256 + (((2 * c + (tp >> 1)) ^ (4 * quad + tq)) << 4) + (tp & 1) * 8));
                    const bf16x8 ka = __builtin_shufflevector(kt, kt, 0, 1, 2, 3, 4, 5, 6, 7);
                    S[c] = __builtin_amdgcn_mfma_f32_16x16x32_bf16(ka, Vs, S[c] * eGl, 0, 0, 0);
                }
                asm volatile("s_waitcnt lgkmcnt(0)" ::: "memory"); __builtin_amdgcn_s_barrier(); asm volatile("" ::: "memory");
            }
#pragma unroll
            for (int c = 0; c < 8; ++c)
#pragma unroll
                for (int r = 0; r < 4; ++r) st[(16 * c + r) * 128] = S[c][r];
        }
        __syncthreads();
    }
}

__device__ __forceinline__ void phase_gnorm(const Args& a) {
    const int wave = wave_id(), lane = threadIdx.x & 63;
    unsigned char* ws = a.ws;
    const bf16_t* O = (const bf16_t*)(ws + WS_SLOTS + 6 * SLOT); const bf16_t* Z = (const bf16_t*)(ws + WS_SLOTS + 3 * SLOT); unsigned char* ON = ws + WS_SLOTS + 1 * SLOT;
    const int gw = blockIdx.x * 8 + wave, NGW = gridDim.x * 8;
    float gn[8]; ldf8(a.in[I_GNG] + (lane & 15) * 8, gn);
    for (int it0 = gw; it0 < MS * 2; it0 += 4 * NGW) {
        u32x4 ow[4], zw[4]; size_t off[4];
#pragma unroll
        for (int q = 0; q < 4; ++q) { const int it = it0 + q * NGW; off[q] = (size_t)(it >> 1) * D + (it & 1) * 512 + lane * 8;
            if (it < MS * 2) { ow[q] = *(const u32x4*)(O + off[q]); zw[q] = *(const u32x4*)(Z + off[q]); } }
#pragma unroll
        for (int q = 0; q < 4; ++q) { const int it = it0 + q * NGW; if (it < MS * 2) {
            float ov[8] = {bflo(ow[q].x), bfhi(ow[q].x), bflo(ow[q].y), bfhi(ow[q].y), bflo(ow[q].z), bfhi(ow[q].z), bflo(ow[q].w), bfhi(ow[q].w)};
            float zv[8] = {bflo(zw[q].x), bfhi(zw[q].x), bflo(zw[q].y), bfhi(zw[q].y), bflo(zw[q].z), bfhi(zw[q].z), bflo(zw[q].w), bfhi(zw[q].w)};
            float r[8], ss = 0.f;
#pragma unroll
            for (int i = 0; i < 8; ++i) ss += ov[i] * ov[i];
            ss += __shfl_xor(ss, 1); ss += __shfl_xor(ss, 2); ss += __shfl_xor(ss, 4); ss += __shfl_xor(ss, 8);
            const float rs = 1.0f / sqrtf(ss * (1.0f / HD) + EPS);
#pragma unroll
            for (int i = 0; i < 8; ++i) r[i] = ov[i] * rs * gn[i] * (zv[i] * sigmoidf_(zv[i]));
            st8_fp8(ON + off[q], r); } }
    }
}

__device__ __forceinline__ void phase_router(const Args& a, int seg, LAS unsigned char* lds) {
    const int tid = threadIdx.x, wave = wave_id(), lane = threadIdx.x & 63;
    unsigned char* ws = a.ws;
    const bf16_t* hsrc = (const bf16_t*)a.out; unsigned char* hb = ws + WS_SLOTS + 9 * SLOT; const bf16_t* wrt = (const bf16_t*)(ws + WS_WR);
    float* rs2 = (float*)(ws + WS_RS2); int* tope = (int*)(ws + WS_TOPE); float* topw = (float*)(ws + WS_TOPW); int* hist = (int*)(ws + WS_HIST); int* rowtok = (int*)(ws + WS_ROWTOK);
    LAS int* lhist = (LAS int*)lds; LAS float* lg = (LAS float*)(lds + 1024) + wave * (16 * 33);
    const int tk = lane & 15, quad = lane >> 4;
    for (int i = blockIdx.x * 512 + tid; i < MAXT * 256; i += gridDim.x * 512) rowtok[i] = 0;
    for (int g = blockIdx.x; g < NG; g += gridDim.x) {
        if (tid < 32) lhist[tid] = 0;
        __syncthreads();
        const int r = g * 128 + wave * 16 + tk; const int Rg = grow(seg, r);
        const bf16_t* hr = hsrc + (size_t)Rg * (2 * D) + quad * 8; unsigned char* ho = hb + (size_t)r * D + quad * 8;
        const bf16_t* w0 = wrt + (size_t)tk * D + quad * 8; const bf16_t* w1 = w0 + 16 * D;
        f32x4 acc0 = {0.f, 0.f, 0.f, 0.f}, acc1 = {0.f, 0.f, 0.f, 0.f}; float ss = 0.f;
        u32x4 keep[32];
#pragma unroll
        for (int ks = 0; ks < 32; ++ks) {
            const u32x4 k = *(const u32x4*)(hr + ks * 32); keep[ks] = k;
            const float e0 = bflo(k.x), e1 = bfhi(k.x), e2 = bflo(k.y), e3 = bfhi(k.y), e4 = bflo(k.z), e5 = bfhi(k.z), e6 = bflo(k.w), e7 = bfhi(k.w);
            ss += (e0 * e0 + e1 * e1) + (e2 * e2 + e3 * e3) + (e4 * e4 + e5 * e5) + (e6 * e6 + e7 * e7);
        }
        ss += __shfl_xor(ss, 16); ss += __shfl_xor(ss, 32);
        const float rs = 1.0f / sqrtf(ss * (1.0f / D) + EPS);
        asm volatile("" ::: "memory");
#pragma unroll
        for (int ks = 0; ks < 32; ++ks) {
            u32x4 k = keep[ks]; asm volatile("" : "+v"(k));
            const float e0 = bflo(k.x) * rs, e1 = bfhi(k.x) * rs, e2 = bflo(k.y) * rs, e3 = bfhi(k.y) * rs, e4 = bflo(k.z) * rs, e5 = bfhi(k.z) * rs, e6 = bflo(k.w) * rs, e7 = bfhi(k.w) * rs;
            u32x4 p; p.x = cvt_pk_bf16(e0, e1); p.y = cvt_pk_bf16(e2, e3); p.z = cvt_pk_bf16(e4, e5); p.w = cvt_pk_bf16(e6, e7);
            { u32x2 p8; p8.x = cvt_pk4_fp8(e0, e1, e2, e3); p8.y = cvt_pk4_fp8(e4, e5, e6, e7); *(u32x2*)(ho + ks * 32) = p8; }
            const bf16x8 f0 = *(const bf16x8*)(w0 + ks * 32), f1 = *(const bf16x8*)(w1 + ks * 32);
            acc0 = __builtin_amdgcn_mfma_f32_16x16x32_bf16(f0, __builtin_bit_cast(bf16x8, p), acc0, 0, 0, 0);
            acc1 = __builtin_amdgcn_mfma_f32_16x16x32_bf16(f1, __builtin_bit_cast(bf16x8, p), acc1, 0, 0, 0);
            if ((ks & 3) == 3) asm volatile("" ::: "memory");
        }
#pragma unroll
        for (int j = 0; j < 4; ++j) { lg[tk * 33 + quad * 4 + j] = acc0[j] + a.in[I_BR][quad * 4 + j]; lg[tk * 33 + 16 + quad * 4 + j] = acc1[j] + a.in[I_BR][16 + quad * 4 + j]; }
        LDS_WAIT();
        if (lane < 16) {
            float v0 = -3.0e38f, v1 = -3.0e38f, v2 = -3.0e38f, v3 = -3.0e38f; int i0 = 0, i1 = 0, i2 = 0, i3 = 0;
            for (int e = 0; e < NE; ++e) { const float xv = lg[lane * 33 + e];
                if (xv > v3) { if (xv > v2) { v3 = v2; i3 = i2; if (xv > v1) { v2 = v1; i2 = i1; if (xv > v0) { v1 = v0; i1 = i0; v0 = xv; i0 = e; } else { v1 = xv; i1 = e; } } else { v2 = xv; i2 = e; } } else { v3 = xv; i3 = e; } } }
            const float e1 = expf(v1 - v0), e2 = expf(v2 - v0), e3 = expf(v3 - v0), inv = 1.0f / (1.0f + e1 + e2 + e3);
            *(i32x4*)(tope + (size_t)r * 4) = (i32x4){i0, i1, i2, i3}; *(f32x4*)(topw + (size_t)r * 4) = (f32x4){inv, e1 * inv, e2 * inv, e3 * inv};
            rs2[r] = rs;
            atomicAdd((int*)&lhist[i0], 1); atomicAdd((int*)&lhist[i1], 1); atomicAdd((int*)&lhist[i2], 1); atomicAdd((int*)&lhist[i3], 1);
        }
        __syncthreads();
        if (tid < 32) hist[g * 32 + tid] = lhist[tid];
        __syncthreads();
    }
}

__device__ __forceinline__ void phase_positions(const Args& a, LAS unsigned char* lds) {
    const int tid = threadIdx.x, wave = wave_id(), lane = threadIdx.x & 63;
    unsigned char* ws = a.ws;
    const int* hist = (const int*)(ws + WS_HIST); const int* tope = (const int*)(ws + WS_TOPE); int* dest = (int*)(ws + WS_DEST); int* rowtok = (int*)(ws + WS_ROWTOK); int* meta = (int*)(ws + WS_META);
    LAS int* tot = (LAS int*)lds; LAS int* pre = tot + 32; LAS int* pstart = pre + 32; LAS int* wcnt = pstart + 32;
    for (int g = blockIdx.x; g < NG; g += gridDim.x) {
        if (tid < 64) tot[tid] = 0;
        __syncthreads();
        { const int e = tid & 31, part = tid >> 5; int t_ = 0, p_ = 0;
          for (int gg = part; gg < NG; gg += 16) { const int hv = hist[gg * 32 + e]; t_ += hv; if (gg < g) p_ += hv; }
          atomicAdd((int*)&tot[e], t_); atomicAdd((int*)&pre[e], p_); }
        __syncthreads();
        if (tid == 0) { int run = 0; for (int e = 0; e < NE; ++e) { pstart[e] = run; run += ((tot[e] + 255) >> 8) << 8; } if (g == 0) meta[0] = run >> 8; }
        __syncthreads();
        if (g == 0 && tid < 32) { const int t0 = pstart[tid] >> 8, t1 = t0 + ((tot[tid] + 255) >> 8); for (int t = t0; t < t1; ++t) meta[64 + t] = tid; }
        const int tokr = g * 128 + (tid >> 2), kx = tid & 3; const int my_e = tope[(size_t)tokr * 4 + kx];
        int rk = 0;
#pragma nounroll
        for (int e = 0; e < NE; ++e) { const unsigned long long mask = __ballot(my_e == e); if (my_e == e) rk = __popcll(mask & ((1ull << lane) - 1ull)); if (lane == 0) wcnt[wave * 32 + e] = __popcll(mask); }
        __syncthreads();
        int off = 0;
        for (int w = 0; w < wave; ++w) off += wcnt[w * 32 + my_e];
        const int dst = pstart[my_e] + pre[my_e] + off + rk;
        dest[(size_t)tokr * 4 + kx] = dst; rowtok[dst] = tokr;
        __syncthreads();
    }
}

__device__ __forceinline__ void phase_combine(const Args& a, int seg) {
    const int wave = wave_id(), lane = threadIdx.x & 63;
    unsigned char* ws = a.ws;
    const unsigned char* Y = ws + WS_Y; const int* dest = (const int*)(ws + WS_DEST); const float* topw = (const float*)(ws + WS_TOPW);
    const int gw = blockIdx.x * 8 + wave, NGW = gridDim.x * 8;
    f32x4 gf[4];
#pragma unroll
    for (int j = 0; j < 4; ++j) gf[j] = *(const f32x4*)(a.in[I_NFIN] + lane * 4 + 256 * j);
    for (int r = gw; r < MS; r += NGW) {
        float* hp = a.out + (size_t)grow(seg, r) * D + lane * 4; const bf16_t* hb16 = (const bf16_t*)(a.out + (size_t)grow(seg, r) * D) + lane * 4;
        const i32x4 dd = *(const i32x4*)(dest + (size_t)r * 4); const f32x4 ww = *(const f32x4*)(topw + (size_t)r * 4);
        f32x4 v[4];
#pragma unroll
        for (int j = 0; j < 4; ++j) { const u32x2 hw = *(const u32x2*)(hb16 + 256 * j); v[j] = (f32x4){bflo(hw.x), bfhi(hw.x), bflo(hw.y), bfhi(hw.y)}; }
#pragma unroll
        for (int k = 0; k < 4; ++k) { const unsigned char* yr = Y + (size_t)dd[k] * D + lane * 4; const float wk = ww[k];
#pragma unroll
            for (int j = 0; j < 4; ++j) { const unsigned p = *(const unsigned*)(yr + 256 * j);
                const f32x2 lo = __builtin_amdgcn_cvt_pk_f32_fp8((int)p, false), hi = __builtin_amdgcn_cvt_pk_f32_fp8((int)p, true);
                v[j][0] += wk * lo.x; v[j][1] += wk * lo.y; v[j][2] += wk * hi.x; v[j][3] += wk * hi.y; } }
        float ss = 0.f;
#pragma unroll
        for (int j = 0; j < 4; ++j) ss += (v[j][0] * v[j][0] + v[j][1] * v[j][1]) + (v[j][2] * v[j][2] + v[j][3] * v[j][3]);
#pragma unroll
        for (int o = 1; o < 64; o <<= 1) ss += __shfl_xor(ss, o);
        const float rs = 1.0f / sqrtf(ss * (1.0f / D) + EPS);
#pragma unroll
        for (int j = 0; j < 4; ++j) *(f32x4*)(hp + 256 * j) = v[j] * rs * gf[j];
    }
}

constexpr int NPH = 14;
__device__ __forceinline__ bool in_range(int k) { const Args a = load_args(); return a.ph_lo <= k && k < a.ph_hi; }
__device__ __forceinline__ bool seg_on(int sgi) { const Args a = load_args(); return a.seg_lo <= sgi && sgi < a.seg_hi; }
__device__ __forceinline__ bool do_pro() { const Args a = load_args(); return a.do_pro != 0; }
__global__ void __launch_bounds__(512, 2) hyb_fwd(Args args_unused) {
    extern __shared__ __attribute__((aligned(16))) unsigned char lds_raw[];
    LAS unsigned char* lds = (LAS unsigned char*)lds_raw;
    const int tid = threadIdx.x;
    volatile LAS unsigned* MISC = (volatile LAS unsigned*)(lds + MISC_OFF);
    if (tid < 32) MISC[tid] = 0u;
    __syncthreads();
    if (!MK_MULTI) { const Args a0 = load_args(); (void)xcd_barrier_post((unsigned*)(a0.ws + WS_CTL) + CW_BAR, MISC + 8); }
#define GRID_BAR() do { if (!MK_MULTI) { XcdBarrier b_; { const Args ab_ = load_args(); b_.bar = (unsigned*)(ab_.ws + WS_CTL) + CW_BAR; } b_.x = xb_xcc_id(); b_.st = (volatile LAS unsigned*)(lds + MISC_OFF) + 8; xcd_barrier(b_); } } while (0)
#define IN(k) ((ONLY < 0 || ONLY == (k)) && in_range(k))
#define SEG_ON(s) seg_on(s)
#define DO_PRO do_pro()
    if ((ONLY < 0 || ONLY == 99) && DO_PRO) REPS(20) { const Args args = load_args(); phase_prep(args, lds); GRID_BAR(); }

#define SEG_BODY(SEGC) if (SEG_ON(SEGC)) { constexpr int seg = (SEGC); \
        if (IN(0)) REPS(0) { const Args args = load_args(); unsigned char* ws = args.ws; (void)ws; phase_cast(args, seg); GRID_BAR(); } \
        if (IN(1)) REPS(1) { const Args args = load_args(); unsigned char* ws = args.ws; (void)ws; \
            pg8::SchedDense S; S.init(MS / 256, NIN / 256, gridDim.x, blockIdx.x, 4); S.A = (const char*)(ws + WS_SLOTS + 9 * SLOT); S.B = (const char*)(ws + WS_WIN); \
            pg8::EpiInProj E{(bf16_t*)(ws + WS_SLOTS), (const float*)(ws + WS_RS1), args.out, seg}; \
            pg8::gemm_phase<pg8::EpiInProj, pg8::SchedDense, PG8_ALIGN, PG8_SP2>(lds, S, E); \
            GRID_BAR(); \
        } \
        if (IN(2)) REPS(2) { const Args args = load_args(); unsigned char* ws = args.ws; (void)ws; phase_sconv(args, seg); }   \
        if (IN(3)) REPS(3) { const Args args = load_args(); unsigned char* ws = args.ws; (void)ws; phase_qkvconv(args, seg); GRID_BAR(); } \
        if (IN(4)) REPS(4) { const Args args = load_args(); unsigned char* ws = args.ws; (void)ws; phase_gdnprep(args, lds); GRID_BAR(); } \
        if (IN(5)) REPS(5) { const Args args = load_args(); unsigned char* ws = args.ws; (void)ws; phase_gdnseq(args, seg, lds); GRID_BAR(); } \
        if (IN(6)) REPS(6) { const Args args = load_args(); unsigned char* ws = args.ws; (void)ws; phase_gnorm(args); GRID_BAR(); } \
        if (IN(7)) REPS(7) { const Args args = load_args(); unsigned char* ws = args.ws; (void)ws; \
            { pg8::SchedMerge S; S.init(MS / 256, 4, gridDim.x, blockIdx.x); S.A0 = (const char*)(ws + WS_SLOTS + 1 * SLOT); S.B0 = (const char*)(ws + WS_WOG); S.A1 = (const char*)(ws + WS_SLOTS + 10 * SLOT); S.B1 = (const char*)(ws + WS_WOS); \
              pg8::EpiMerge E{(bf16_t*)(ws + WS_SLOTS + 2 * SLOT), (const bf16_t*)args.out, (const bf16_t*)(ws + WS_SLOTS + 8 * SLOT), seg}; \
              pg8::gemm_phase<pg8::EpiMerge, pg8::SchedMerge, PG8_ALIGN, PG8_SP2>(lds, S, E); } \
            GRID_BAR(); \
        } \
        if (IN(8)) REPS(8) { const Args args = load_args(); unsigned char* ws = args.ws; (void)ws; \
            pg8::SchedDense S; S.init(MS / 256, 4, gridDim.x, blockIdx.x); S.A = (const char*)(ws + WS_SLOTS + 2 * SLOT); S.B = (const char*)(ws + WS_WMX); \
            pg8::EpiMix E{(const bf16_t*)(ws + WS_SLOTS + 9 * SLOT), (const float*)(ws + WS_RS1), args.out, seg}; \
            pg8::gemm_phase<pg8::EpiMix, pg8::SchedDense, PG8_ALIGN, PG8_SP2>(lds, S, E); \
            GRID_BAR(); \
        } \
        if (IN(9)) REPS(9) { const Args args = load_args(); unsigned char* ws = args.ws; (void)ws; phase_router(args, seg, lds); GRID_BAR(); } \
        if (IN(10)) REPS(10) { const Args args = load_args(); unsigned char* ws = args.ws; (void)ws; phase_positions(args, lds); GRID_BAR(); } \
        if (IN(11)) REPS(11) { const Args args = load_args(); unsigned char* ws = args.ws; (void)ws; \
            const int* meta = (const int*)(ws + WS_META); const int ntl = meta[0]; LAS int* tl = (LAS int*)(lds + TILE_E_OFF); \
            for (int i = threadIdx.x; i < ntl; i += 512) tl[i] = meta[64 + i]; \
            __syncthreads(); \
            pg8::SchedMoe1 S; S.init(ntl, 8, gridDim.x, blockIdx.x, 4); S.A = (const char*)(ws + WS_SLOTS + 9 * SLOT); S.B = (const char*)(ws + WS_WGU); S.rowtok = (const int*)(ws + WS_ROWTOK); S.tile_e = tl; \
            pg8::EpiMoe1 E{ws + WS_HID, tl, (const bf16_t*)(ws + WS_BGU16)}; \
            pg8::gemm_phase<pg8::EpiMoe1, pg8::SchedMoe1, PG8_ALIGN, PG8_SP2>(lds, S, E); \
            GRID_BAR(); \
        } \
        if (IN(12)) REPS(12) { const Args args = load_args(); unsigned char* ws = args.ws; (void)ws; \
            const int* meta = (const int*)(ws + WS_META); const int ntl = meta[0]; LAS int* tl = (LAS int*)(lds + TILE_E_OFF); \
            for (int i = threadIdx.x; i < ntl; i += 512) tl[i] = meta[64 + i]; \
            __syncthreads(); \
            pg8::SchedMoe2 S; S.init(ntl, 4, gridDim.x, blockIdx.x, 4); S.A = (const char*)(ws + WS_HID); S.B = (const char*)(ws + WS_WDN); S.tile_e = tl; \
            pg8::EpiMoe2 E{ws + WS_Y, tl, (const bf16_t*)(ws + WS_BDN16)}; \
            pg8::gemm_phase<pg8::EpiMoe2, pg8::SchedMoe2, PG8_ALIGN, PG8_SP2>(lds, S, E); \
            GRID_BAR(); \
        } \
        if (IN(13)) REPS(13) { const Args args = load_args(); unsigned char* ws = args.ws; (void)ws; phase_combine(args, seg); } \
    }
    SEG_BODY(0)
    SEG_BODY(1)
    static_assert(NSEG == 2, "one SEG_BODY per segment");
#undef SEG_BODY
#undef IN
#undef GRID_BAR
}

extern "C" void kernel_launch(void* const* d_in, const int* in_sizes, int n_in, void* d_out, int out_size, void* d_ws, size_t ws_size, hipStream_t stream) {
    static int grid = 0;
    if (grid == 0) {
        if (n_in != 19 || out_size != NB * SEQ * D || ws_size < WS_END) { fprintf(stderr, "kernel_launch: unexpected shapes / workspace (%d inputs, out %d, ws %zu < %zu)\n", n_in, out_size, ws_size, (size_t)WS_END); grid = -1; return; }
        int dev = 0, cus = 0;
        if (hipGetDevice(&dev) != hipSuccess || hipDeviceGetAttribute(&cus, hipDeviceAttributeMultiprocessorCount, dev) != hipSuccess) { grid = -1; return; }
        if (hipFuncSetAttribute((const void*)hyb_fwd, hipFuncAttributeMaxDynamicSharedMemorySize, LDS_BYTES) != hipSuccess) { fprintf(stderr, "kernel_launch: hipFuncSetAttribute failed\n"); grid = -1; return; }
        int per_cu = 0;
        if (hipOccupancyMaxActiveBlocksPerMultiprocessor(&per_cu, (const void*)hyb_fwd, 512, LDS_BYTES) != hipSuccess || per_cu < 1) fprintf(stderr, "kernel_launch: occupancy query reports %d\n", per_cu);
        (void)hipGetLastError();
        grid = cus;
    }
    if (grid < 0) return;
    (void)in_sizes;
    hipMemsetAsync((char*)d_ws + WS_CTL, 0, CTL_BYTES, stream);
    Args a{};
    for (int i = 0; i < 19; ++i) a.in[i] = (const float*)d_in[i];
    a.out = (float*)d_out; a.ws = (unsigned char*)d_ws;
#if MK_MULTI
    a.do_pro = 1; a.seg_lo = 0; a.seg_hi = 0; a.ph_lo = 0; a.ph_hi = 0;
    hipLaunchKernelGGL(hyb_fwd, dim3(grid), dim3(512), LDS_BYTES, stream, a);
    for (int s = 0; s < NSEG; ++s)
        for (int p = 0; p < NPH; ++p) { a.do_pro = 0; a.seg_lo = s; a.seg_hi = s + 1; a.ph_lo = p; a.ph_hi = p + 1; hipLaunchKernelGGL(hyb_fwd, dim3(grid), dim3(512), LDS_BYTES, stream, a); }
#else
    a.do_pro = 1; a.seg_lo = 0; a.seg_hi = NSEG; a.ph_lo = 0; a.ph_hi = NPH;
    hipLaunchKernelGGL(hyb_fwd, dim3(grid), dim3(512), LDS_BYTES, stream, a);
#endif
}
```
